# Optimizing an MI355X kernel written in HIP

```python
import math
import jax
import jax.numpy as jnp
from jax import lax
import numpy as np

D_MODEL = 2048
BATCH = 1
SEQ = 16384
DEPTH = 4
DEC_BATCH = 32
DEC_SEQ = 32
PAST_LEN = 4096

CHUNK = 64
EPS = 1e-6
CONV_W = 3
W_CONV = 1024
W_SSM = 1024
SSM_GROUP = 16
SSM_GROUPS = W_SSM // SSM_GROUP
SSM_STATE = 64
SSM_SCAN_BLOCK = 1024
W_SGU = 1024
SGU_CHUNK = 128
SGU_HEADS = 8
SGU_HEAD_DIM = W_SGU // SGU_HEADS
N_BRANCH = 3
D_FF = -(-8 * D_MODEL // (3 * 256)) * 256
SPLITS = (W_CONV, 2 * W_CONV, 3 * W_CONV, 3 * W_CONV + W_SSM, 3 * W_CONV + W_SSM + W_SGU)
D_IN = 3 * W_CONV + W_SSM + 2 * W_SGU

kernel_name = 'hybrid_streaming_encoder_step'


def rms_norm(x, g):
    x32 = x.astype(jnp.float32)
    y = x32 * lax.rsqrt(jnp.mean(x32 * x32, axis=-1, keepdims=True) + EPS)
    return (y * g.astype(jnp.float32)).astype(x.dtype)


def layer_norm(x, g):
    x32 = x.astype(jnp.float32)
    xc = x32 - jnp.mean(x32, axis=-1, keepdims=True)
    y = xc * lax.rsqrt(jnp.mean(xc * xc, axis=-1, keepdims=True) + EPS)
    return (y * g.astype(jnp.float32)).astype(x.dtype)


def _cplx(re, im):
    return lax.complex(re.astype(jnp.float32), im.astype(jnp.float32))


def short_conv(z, buf, w):
    L = z.shape[1]
    zp = jnp.concatenate([buf.astype(z.dtype), z], axis=1)
    y = sum(w[k] * zp[:, k:k + L] for k in range(CONV_W))
    return y, zp[:, L:]


def s5_discretize(lam_re, lam_im, log_dt, b_re, b_im):
    lam = _cplx(lam_re, lam_im)
    dt = jnp.exp(log_dt.astype(jnp.float32))[:, None]
    lam_bar = jnp.exp(lam * dt)
    b_bar = ((lam_bar - 1.0) / lam)[:, :, None] * _cplx(b_re, b_im)
    return lam_bar, b_bar


def _affine_combine(left, right):
    a_l, b_l = left
    a_r, b_r = right
    return a_r * a_l, a_r * b_l + b_r


def s5_scan(u, s0, lam_bar, b_bar, c, d):
    nb, L, _ = u.shape
    blk = math.gcd(L, SSM_SCAN_BLOCK)
    ub = u.reshape(nb, L // blk, blk, SSM_GROUPS, SSM_GROUP).transpose(1, 0, 2, 3, 4)

    def block_step(s, u_blk):
        bu = jnp.einsum('blgi,gpi->blgp', u_blk.astype(jnp.complex64), b_bar)
        a = jnp.broadcast_to(lam_bar, bu.shape)
        a_cum, h = lax.associative_scan(_affine_combine, (a, bu), axis=1)
        h = h + a_cum * s[:, None]
        y = jnp.einsum('blgp,gip->blgi', h, c).real
        return h[:, -1], y

    s_last, y = lax.scan(block_step, s0, ub)
    y = y.transpose(1, 0, 2, 3, 4).reshape(nb, L, W_SSM)
    return y + d.astype(jnp.float32) * u, s_last


def spatial_gate(u, v, w_s, b_s):
    nb, L, _ = v.shape
    n = -(-L // SGU_CHUNK)
    vp = jnp.pad(v, ((0, 0), (0, n * SGU_CHUNK - L), (0, 0)))
    vp = vp.reshape(nb, n, SGU_CHUNK, SGU_HEADS, SGU_HEAD_DIM)
    mask = jnp.tril(jnp.ones((SGU_CHUNK, SGU_CHUNK), dtype=bool))
    w = jnp.where(mask, w_s, 0)
    mix = jnp.einsum('hts,bnshd->bnthd', w, vp) + b_s.T[:, :, None]
    mix = mix.reshape(nb, n * SGU_CHUNK, W_SGU)[:, :L]
    return u * mix


def mixer(xn, conv_buf, s0, w_in, conv_w, w_conv_out, lam_bar, b_bar, c_ssm, d_ssm,
          w_glu, b_glu, w_ssm_out, ln_v_g, w_sgu_s, b_sgu_s, w_sgu_out, w_gate, b_gate, w_o):
    h = xn @ w_in
    b_g, c_g, h_c, u_s, u_g, v_g = jnp.split(h, SPLITS, axis=-1)
    z_conv, conv_new = short_conv(c_g * h_c, conv_buf, conv_w)
    y_a = (b_g * z_conv) @ w_conv_out
    y_s, s_new = s5_scan(u_s.astype(jnp.float32), s0, lam_bar, b_bar, c_ssm, d_ssm)
    y_s = jax.nn.gelu(y_s).astype(xn.dtype)
    y_s = y_s * jax.nn.sigmoid(y_s @ w_glu + b_glu)
    y_b = y_s @ w_ssm_out
    v_n = layer_norm(jax.nn.gelu(v_g), ln_v_g)
    y_c = spatial_gate(jax.nn.gelu(u_g), v_n, w_sgu_s, b_sgu_s) @ w_sgu_out
    gates = jax.nn.sigmoid(jnp.einsum('bld,dke->blke', xn, w_gate) + b_gate)
    merged = gates[:, :, 0] * y_a + gates[:, :, 1] * y_b + gates[:, :, 2] * y_c
    return merged @ w_o, conv_new, s_new, v_n


def swiglu(xn, w_ffn_in, w_ffn_out):
    g, u = jnp.split(xn @ w_ffn_in, 2, axis=-1)
    return (jax.nn.silu(g) * u) @ w_ffn_out


def setup_inputs(seed: int = 0) -> dict:
    key = jax.random.key(seed)
    ks = iter(jax.random.split(key, 40))
    f32 = jnp.float32

    def nrm(shape, scale):
        return jax.random.normal(next(ks), shape, f32) * scale

    n_idx = jnp.arange(SSM_STATE, dtype=f32)
    return {
        'x_prompt': nrm((BATCH, SEQ, D_MODEL), 1.0),
        'x_sample': nrm((DEC_BATCH, DEC_SEQ, D_MODEL), 1.0),
        'cache_conv': nrm((DEPTH, DEC_BATCH, CONV_W - 1, W_CONV), 1.0),
        'state_ssm_re': nrm((DEPTH, DEC_BATCH, SSM_GROUPS, SSM_STATE), 0.5),
        'state_ssm_im': nrm((DEPTH, DEC_BATCH, SSM_GROUPS, SSM_STATE), 0.5),
        'norm_mix_g': 1.0 + nrm((DEPTH, D_MODEL), 0.01),
        'w_in': nrm((DEPTH, D_MODEL, D_IN), D_MODEL ** -0.5),
        'conv_w': nrm((DEPTH, CONV_W, W_CONV), 0.5),
        'w_conv_out': nrm((DEPTH, W_CONV, D_MODEL), W_CONV ** -0.5),
        'ssm_lam_re': -0.5 + nrm((DEPTH, SSM_GROUPS, SSM_STATE), 0.01),
        'ssm_lam_im': jnp.pi * n_idx + nrm((DEPTH, SSM_GROUPS, SSM_STATE), 0.01),
        'ssm_log_dt': jax.random.uniform(next(ks), (DEPTH, SSM_GROUPS), f32, math.log(1e-3), math.log(1e-1)),
        'ssm_b_re': nrm((DEPTH, SSM_GROUPS, SSM_STATE, SSM_GROUP), (2 * SSM_GROUP) ** -0.5),
        'ssm_b_im': nrm((DEPTH, SSM_GROUPS, SSM_STATE, SSM_GROUP), (2 * SSM_GROUP) ** -0.5),
        'ssm_c_re': nrm((DEPTH, SSM_GROUPS, SSM_GROUP, SSM_STATE), (2 * SSM_STATE) ** -0.5),
        'ssm_c_im': nrm((DEPTH, SSM_GROUPS, SSM_GROUP, SSM_STATE), (2 * SSM_STATE) ** -0.5),
        'ssm_d': nrm((DEPTH, W_SSM), 1.0),
        'w_glu': nrm((DEPTH, W_SSM, W_SSM), W_SSM ** -0.5),
        'b_glu': nrm((DEPTH, W_SSM), 0.01),
        'w_ssm_out': nrm((DEPTH, W_SSM, D_MODEL), W_SSM ** -0.5),
        'ln_v_g': 1.0 + nrm((DEPTH, W_SGU), 0.01),
        'w_sgu_s': nrm((DEPTH, SGU_HEADS, SGU_CHUNK, SGU_CHUNK), 0.5 * SGU_CHUNK ** -0.5),
        'b_sgu_s': 1.0 + nrm((DEPTH, SGU_HEADS, SGU_CHUNK), 0.01),
        'w_sgu_out': nrm((DEPTH, W_SGU, D_MODEL), W_SGU ** -0.5),
        'w_gate': nrm((DEPTH, D_MODEL, N_BRANCH, D_MODEL), D_MODEL ** -0.5),
        'b_gate': nrm((DEPTH, N_BRANCH, D_MODEL), 0.01),
        'w_o': nrm((DEPTH, D_MODEL, D_MODEL), D_MODEL ** -0.5),
        'norm_ffn_g': 1.0 + nrm((DEPTH, D_MODEL), 0.01),
        'w_ffn_in': nrm((DEPTH, D_MODEL, 2 * D_FF), D_MODEL ** -0.5),
        'w_ffn_out': nrm((DEPTH, D_FF, D_MODEL), D_FF ** -0.5),
        'norm_final_g': 1.0 + nrm((D_MODEL,), 0.01),
    }


def reference(x_prompt, x_sample, cache_conv, state_ssm_re, state_ssm_im, norm_mix_g, w_in, conv_w,
              w_conv_out, ssm_lam_re, ssm_lam_im, ssm_log_dt, ssm_b_re, ssm_b_im, ssm_c_re, ssm_c_im,
              ssm_d, w_glu, b_glu, w_ssm_out, ln_v_g, w_sgu_s, b_sgu_s, w_sgu_out, w_gate, b_gate, w_o,
              norm_ffn_g, w_ffn_in, w_ffn_out, norm_final_g):
    xp, xs = x_prompt, x_sample
    nbp = x_prompt.shape[0]
    conv_p, re_p, im_p, conv_s, re_s, im_s, v_s = [], [], [], [], [], [], []
    for l in range(DEPTH):
        lam_bar, b_bar = s5_discretize(ssm_lam_re[l], ssm_lam_im[l], ssm_log_dt[l], ssm_b_re[l], ssm_b_im[l])
        c_ssm = _cplx(ssm_c_re[l], ssm_c_im[l])

        def layer(x, conv_buf, s0):
            out, conv_new, s_new, v_n = mixer(
                rms_norm(x, norm_mix_g[l]), conv_buf, s0, w_in[l], conv_w[l], w_conv_out[l],
                lam_bar, b_bar, c_ssm, ssm_d[l], w_glu[l], b_glu[l], w_ssm_out[l], ln_v_g[l],
                w_sgu_s[l], b_sgu_s[l], w_sgu_out[l], w_gate[l], b_gate[l], w_o[l])
            x = x + out
            x = x + swiglu(rms_norm(x, norm_ffn_g[l]), w_ffn_in[l], w_ffn_out[l])
            return x, conv_new, s_new, v_n

        xp, cp, sp, _ = layer(xp, jnp.zeros((nbp, CONV_W - 1, W_CONV), xp.dtype),
                              jnp.zeros((nbp, SSM_GROUPS, SSM_STATE), jnp.complex64))
        xs, cs, ss, vs = layer(xs, cache_conv[l], _cplx(state_ssm_re[l], state_ssm_im[l]))
        conv_p.append(cp)
        re_p.append(sp.real)
        im_p.append(sp.imag)
        conv_s.append(cs)
        re_s.append(ss.real)
        im_s.append(ss.imag)
        v_s.append(vs)

    y_prompt = rms_norm(xp, norm_final_g)
    y_sample = rms_norm(xs, norm_final_g)
    sdt = state_ssm_re.dtype
    new_conv_prompt = jnp.stack(conv_p)
    new_ssm_re_prompt = jnp.stack(re_p).astype(sdt)
    new_ssm_im_prompt = jnp.stack(im_p).astype(sdt)
    new_conv_sample = jnp.stack(conv_s)
    new_ssm_re_sample = jnp.stack(re_s).astype(sdt)
    new_ssm_im_sample = jnp.stack(im_s).astype(sdt)
    new_sgu_v_sample = jnp.stack(v_s)
    return (y_prompt, y_sample, new_conv_prompt, new_ssm_re_prompt, new_ssm_im_prompt,
            new_conv_sample, new_ssm_re_sample, new_ssm_im_sample, new_sgu_v_sample)
```

```cpp
#include <hip/hip_runtime.h>
#include <cstdio>
#include <cstdint>
#ifndef PHMASK
#define PHMASK 2047
#endif
#ifndef DUPMASK
#define DUPMASK 0
#endif
#define DUP(bit) for (int rep_ = 0; rep_ < ((DUPMASK & (bit)) ? ((bit) >= 4096 ? 5 : 2) : 1); ++rep_)
namespace pg8 {
#define PG8_LAS __attribute__((address_space(3)))
typedef unsigned short bf16_t;
typedef short bf16x8 __attribute__((ext_vector_type(8)));
typedef float f32x4 __attribute__((ext_vector_type(4)));
typedef unsigned u32x4 __attribute__((ext_vector_type(4)));
typedef int i32x4 __attribute__((ext_vector_type(4)));
constexpr int BM = 256, BK = 64, HALF = 128, HTB = HALF * BK * 2  , STAGE_BYTES = 8 * HTB, NXCD = 8, WGM = 8;

__host__ __device__ __forceinline__ int lds_byte(int r, int c) { const int st = (r >> 4) * 2 + (c >> 5), rr = r & 15, cc = c & 31, ob = rr * 64 + cc * 2; return st * 1024 + (ob ^ (((ob >> 9) & 1) << 5)); }
__host__ __device__ __forceinline__ void stage_rc(int b, int& R, int& C) { const int st = b / 1024, sb = b % 1024, swz = sb ^ (((sb >> 9) & 1) << 5); R = (st >> 1) * 16 + swz / 64; C = (st & 1) * 32 + (swz % 64) / 2; }
__host__ __device__ __forceinline__ int perm32(int rho) { const int n = rho >> 4, i = rho & 15; return 8 * (i >> 2) + 4 * n + (i & 3); }

struct Unit { int pm, pn, kb, k0, nkt, part; };
struct Gemm { const bf16_t* A; const bf16_t* Bt; int M, N, K, lda, ldb; const unsigned char* ws; };
struct StaticOrder {
    int nM, nN, nwg, G, c, nkt, nE, late, nNE, e0;
    __host__ __device__ void init(int M, int N, int G_, int c_, int K, int ME = 0, int late_ = 0, int nNE_ = -1, int e0_ = 0) { nM = M / BM; nN = N / BM; nwg = nM * nN; G = G_; c = c_; nkt = K / BK; nE = ME / BM; late = late_; nNE = nNE_ < 0 ? nN : nNE_; e0 = e0_; }
    __host__ __device__ int place(int pos, int x) const {
        if (late > 0) { const int h = pos >= nN - late, w = h ? late : nN - late, i0 = h ? pos - (nN - late) : pos, i = x < 0 ? i0 : (i0 + (x * w) / NXCD) % w; return h ? i : late + i; }
        return x < 0 ? pos : (pos + (x * nN) / NXCD) % nN; }
    __host__ __device__ __forceinline__ bool next(int i, Unit& u) const {
        const long L = (long)i * G + c; u.kb = 0; u.k0 = 0; u.nkt = nkt; u.part = -1;
        if (L >= nwg) { const long e = L - nwg; if (e >= (long)nE * nNE) return false; u.pm = nM + (int)(e % nE); u.pn = e0 + place((int)(e / nE), -1); return true; }
        int wgid = (int)L; { const int q = nwg / NXCD, r = nwg % NXCD, xcd = wgid % NXCD, off = wgid / NXCD; wgid = (xcd < r ? xcd * (q + 1) : r * (q + 1) + (xcd - r) * q) + off; }
        const int nig = WGM * nN, gid = wgid / nig, fm = gid * WGM, gsz = (nM - fm) < WGM ? (nM - fm) : WGM;
        u.pm = fm + ((wgid % nig) % gsz); u.pn = (wgid % nig) / gsz;
        u.pn = place(u.pn, (nM % 64 == 0 && G % NXCD == 0) ? c % NXCD : -1);
        return true;
    }
    __device__ __forceinline__ void a_ready(const Unit&) const {}
    __device__ __forceinline__ void done(const Unit&) const {}
};
struct ChainOrder : StaticOrder {
    __host__ __device__ __forceinline__ bool next(int i, Unit& u) const { const int t = i / 3; if (!StaticOrder::next(t, u)) return false; u.kb = i - 3 * t; return true; }
};
struct SliceOrder {
    int c, pm0, nkt, S, seg, npn;
    __host__ __device__ void init(int c_, int pm0_, int K, int S_, int seg_, int npn_ = 8) { c = c_; pm0 = pm0_; nkt = K / BK; S = S_; seg = seg_; npn = npn_; }
    __host__ __device__ __forceinline__ bool next(int i, Unit& u) const {
        const int per = S * seg;
        if (i != 0 || c >= 4 * npn * per) return false;
        const int ts = c / per, r = c - per * ts, kb = r / S, sl = r - kb * S;
        u.pm = pm0 + ts / npn; u.pn = ts % npn; u.kb = kb; u.part = r;
        u.k0 = 2 * ((sl * nkt + S) / (2 * S)); u.nkt = 2 * (((sl + 1) * nkt + S) / (2 * S)) - u.k0; return true;
    }
    __device__ __forceinline__ void a_ready(const Unit&) const {}
    __device__ __forceinline__ void done(const Unit&) const {}
};
template <class Epi, class Sched, bool ALIGN_EPI = false, bool SP2 = false, bool F8 = false, bool CONT_IN = false>
__device__ __forceinline__ void gemm_phase(PG8_LAS unsigned char* lds, const Gemm g, const Sched& S, const Epi& E, int tid_, const bool has_link = false, const int lpm = 0, const int lpn = 0, const int lkb = 0, const int lk0 = 0) {
    asm volatile("" : "+v"(tid_));
    const int tid = tid_, wid = __builtin_amdgcn_readfirstlane(tid >> 6), lane = tid & 63, wr = wid >> 2, wc = wid & 3, fr = lane & 15, fq = lane >> 4;
    unsigned voffA[2], voffB[2];
#pragma unroll
    for (int i = 0; i < 2; ++i) { int R, C; stage_rc(tid * 16 + i * 8192, R, C); const int Rb = Epi::PERM ? ((R & ~31) + perm32(R & 31)) : R;
        voffA[i] = (unsigned)(R * g.lda + C) * 2u; voffB[i] = (unsigned)(Rb * g.ldb + C) * 2u; }
    const __amdgpu_buffer_rsrc_t rsrc = __builtin_amdgcn_make_buffer_rsrc((void*)g.ws, (short)0, 0x7fffffff, 0x00020000);
    const unsigned baseA = (unsigned)((const unsigned char*)g.A - g.ws), baseB = (unsigned)((const unsigned char*)g.Bt - g.ws);
    const unsigned kstep = (unsigned)(BK * 2);
    const unsigned kbstep = (unsigned)g.K * 2u;
    const unsigned hstepA = (unsigned)HALF * g.lda * 2u, hstepB = (unsigned)HALF * g.ldb * 2u;
    const unsigned tstepA = 2u * hstepA, tstepB = 2u * hstepB;
    const unsigned ldsw = (unsigned)wid * 1024u;
    const int aoff = lds_byte(wr * 64 + fr, fq * 8), boff = lds_byte(wc * 32 + fr, fq * 8);
#define PG8_SA(b, h) (((b) * 2 + (h)) * HTB)
#define PG8_SB(b, h) ((4 + (b) * 2 + (h)) * HTB)
#define PG8_STAGE(bufoff, goff, voff) do { _Pragma("unroll") for (int _i = 0; _i < 2; ++_i) \
        __builtin_amdgcn_raw_ptr_buffer_load_lds(rsrc, (PG8_LAS void*)(lds + (bufoff) + ldsw + _i * 8192), 16, (voff)[_i], (goff), 0, 0); } while (0)
#define PG8_LDA(dst, b, h) do { _Pragma("unroll") for (int m = 0; m < 4; ++m) _Pragma("unroll") for (int k = 0; k < 2; ++k) dst[m][k] = *(const PG8_LAS bf16x8*)(lds + PG8_SA(b, h) + aoff + m * 2048 + k * 1024); } while (0)
#define PG8_LDB(dst, b, h) do { _Pragma("unroll") for (int n = 0; n < 2; ++n) _Pragma("unroll") for (int k = 0; k < 2; ++k) dst[n][k] = *(const PG8_LAS bf16x8*)(lds + PG8_SB(b, h) + boff + n * 2048 + k * 1024); } while (0)
#define PG8_MMA(ai, bj, At, Bt) do { __builtin_amdgcn_s_setprio(1); _Pragma("unroll") for (int m = 0; m < 4; ++m) _Pragma("unroll") for (int n = 0; n < 2; ++n) _Pragma("unroll") for (int k = 0; k < 2; ++k) { \
        if constexpr (F8) acc[ai][bj][m][n] = __builtin_bit_cast(f32x4, __builtin_amdgcn_mfma_i32_16x16x64_i8(__builtin_bit_cast(i32x4, Bt[n][k]), __builtin_bit_cast(i32x4, At[m][k]), __builtin_bit_cast(i32x4, acc[ai][bj][m][n]), 0, 0, 0)); \
        else acc[ai][bj][m][n] = __builtin_amdgcn_mfma_f32_16x16x32_bf16(Bt[n][k], At[m][k], acc[ai][bj][m][n], 0, 0, 0); } __builtin_amdgcn_s_setprio(0); } while (0)
#define PG8_MMA0(ai, bj, At, Bt) do { __builtin_amdgcn_s_setprio(1); _Pragma("unroll") for (int m = 0; m < 4; ++m) _Pragma("unroll") for (int n = 0; n < 2; ++n) { \
        if constexpr (F8) { acc[ai][bj][m][n] = __builtin_bit_cast(f32x4, __builtin_amdgcn_mfma_i32_16x16x64_i8(__builtin_bit_cast(i32x4, Bt[n][0]), __builtin_bit_cast(i32x4, At[m][0]), (i32x4){0, 0, 0, 0}, 0, 0, 0)); \
                            acc[ai][bj][m][n] = __builtin_bit_cast(f32x4, __builtin_amdgcn_mfma_i32_16x16x64_i8(__builtin_bit_cast(i32x4, Bt[n][1]), __builtin_bit_cast(i32x4, At[m][1]), __builtin_bit_cast(i32x4, acc[ai][bj][m][n]), 0, 0, 0)); } \
        else { acc[ai][bj][m][n] = __builtin_amdgcn_mfma_f32_16x16x32_bf16(Bt[n][0], At[m][0], (f32x4){0.f, 0.f, 0.f, 0.f}, 0, 0, 0); acc[ai][bj][m][n] = __builtin_amdgcn_mfma_f32_16x16x32_bf16(Bt[n][1], At[m][1], acc[ai][bj][m][n], 0, 0, 0); } } \
        __builtin_amdgcn_s_setprio(0); } while (0)
#define PG8_WAIT_V(n) asm volatile("s_waitcnt vmcnt(" #n ")" ::: "memory")
#define PG8_WAIT_L(n) asm volatile("s_waitcnt lgkmcnt(" #n ")" ::: "memory")
#define PG8_BAR __builtin_amdgcn_s_barrier()
#define PG8_SCHED __builtin_amdgcn_sched_barrier(0)
    Unit cur, nxt; int ui = 0;
    if (!S.next(0, cur)) return;
    f32x4 acc[2][2][4][2];
    if constexpr (Epi::CHAIN || !SP2) {
#pragma unroll
    for (int a = 0; a < 2; ++a)
#pragma unroll
        for (int b = 0; b < 2; ++b)
#pragma unroll
            for (int m = 0; m < 4; ++m)
#pragma unroll
                for (int n = 0; n < 2; ++n) acc[a][b][m][n] = (f32x4){0.f, 0.f, 0.f, 0.f};
    }
    bf16x8 At[4][2], B0[2][2], B1[2][2];
    unsigned cA = baseA + (unsigned)cur.pm * tstepA + (unsigned)cur.kb * kbstep + (unsigned)cur.k0 * kstep, cB = baseB + (unsigned)cur.pn * tstepB + (unsigned)cur.kb * kbstep + (unsigned)cur.k0 * kstep;
    S.a_ready(cur);
    if constexpr (CONT_IN) { static_assert(SP2 && ALIGN_EPI && !Epi::CHAIN, "hand-over form"); } else
    if constexpr (SP2) {
        PG8_STAGE(PG8_SB(0, 0), cB, voffB); PG8_STAGE(PG8_SB(0, 1), cB + hstepB, voffB); PG8_STAGE(PG8_SA(0, 0), cA, voffA); PG8_STAGE(PG8_SA(0, 1), cA + hstepA, voffA);
        if (wr == 1) PG8_BAR;
        PG8_WAIT_V(2); PG8_BAR;
        PG8_STAGE(PG8_SB(1, 0), cB + kstep, voffB); PG8_STAGE(PG8_SA(1, 0), cA + kstep, voffA); PG8_STAGE(PG8_SB(1, 1), cB + hstepB + kstep, voffB);
        PG8_WAIT_V(6); PG8_BAR;
    } else {
        PG8_STAGE(PG8_SB(0, 0), cB, voffB); PG8_STAGE(PG8_SA(0, 0), cA, voffA); PG8_STAGE(PG8_SB(0, 1), cB + hstepB, voffB); PG8_STAGE(PG8_SA(0, 1), cA + hstepA, voffA);
        if (wr == 1) PG8_BAR;
        PG8_WAIT_V(4); PG8_BAR;
        PG8_STAGE(PG8_SB(1, 0), cB + kstep, voffB); PG8_STAGE(PG8_SA(1, 0), cA + kstep, voffA); PG8_STAGE(PG8_SB(1, 1), cB + hstepB + kstep, voffB);
        PG8_WAIT_V(6); PG8_BAR;
    }
    for (;;) {
        const bool has_next = S.next(ui + 1, nxt);
        const bool pf_next = has_next || has_link;
        const int qpm = has_next ? nxt.pm : lpm, qpn = has_next ? nxt.pn : lpn, qkb = has_next ? nxt.kb : lkb, qk0 = has_next ? nxt.k0 : lk0;
        const unsigned nA = pf_next ? baseA + (unsigned)qpm * tstepA + (unsigned)qkb * kbstep + (unsigned)qk0 * kstep : cA, nB = pf_next ? baseB + (unsigned)qpn * tstepB + (unsigned)qkb * kbstep + (unsigned)qk0 * kstep : cB;
        const int nt = cur.nkt;
        int t = 0;
        if constexpr (SP2 && !Epi::CHAIN) {
            const unsigned a1 = cA + kstep, a2 = cA + 2u * kstep, b2 = cB + 2u * kstep, a3 = a2 + kstep, b3 = b2 + kstep;
            PG8_LDB(B0, 0, 0); PG8_LDB(B1, 0, 1); PG8_SCHED; PG8_LDA(At, 0, 0); PG8_STAGE(PG8_SA(1, 1), a1 + hstepA, voffA);
            PG8_WAIT_V(8); PG8_WAIT_L(0); PG8_BAR; PG8_MMA0(0, 0, At, B0); PG8_MMA0(0, 1, At, B1); PG8_BAR; PG8_SCHED;
            PG8_LDA(At, 0, 1); PG8_STAGE(PG8_SB(0, 0), b2, voffB); PG8_STAGE(PG8_SB(0, 1), b2 + hstepB, voffB); PG8_STAGE(PG8_SA(0, 0), a2, voffA);
            PG8_WAIT_V(8); PG8_WAIT_L(0); PG8_BAR; PG8_MMA0(1, 0, At, B0); PG8_MMA0(1, 1, At, B1); PG8_BAR; PG8_SCHED;
            PG8_LDB(B0, 1, 0); PG8_LDB(B1, 1, 1); PG8_SCHED; PG8_LDA(At, 1, 0); PG8_STAGE(PG8_SA(0, 1), a2 + hstepA, voffA);
            PG8_WAIT_V(8); PG8_WAIT_L(0); PG8_BAR; PG8_MMA(0, 0, At, B0); PG8_MMA(0, 1, At, B1); PG8_BAR; PG8_SCHED;
            PG8_LDA(At, 1, 1); PG8_STAGE(PG8_SB(1, 0), b3, voffB); PG8_STAGE(PG8_SB(1, 1), b3 + hstepB, voffB); PG8_STAGE(PG8_SA(1, 0), a3, voffA);
            PG8_WAIT_V(8); PG8_WAIT_L(0); PG8_BAR; PG8_MMA(1, 0, At, B0); PG8_MMA(1, 1, At, B1); PG8_BAR; PG8_SCHED;
            t = 2;
        }
        for (; t < nt; t += 2) {
            const bool last = (t == nt - 2);
            const unsigned a1 = cA + (unsigned)(t + 1) * kstep;
            const unsigned a2 = last ? nA : cA + (unsigned)(t + 2) * kstep, b2 = last ? nB : cB + (unsigned)(t + 2) * kstep;
            const unsigned a3 = a2 + kstep, b3 = b2 + kstep;
            if (last && has_next) S.a_ready(nxt);
            if constexpr (SP2) {
            PG8_LDB(B0, 0, 0); PG8_LDB(B1, 0, 1); PG8_SCHED; PG8_LDA(At, 0, 0); PG8_STAGE(PG8_SA(1, 1), a1 + hstepA, voffA);
            PG8_WAIT_V(8); PG8_WAIT_L(0); PG8_BAR; PG8_MMA(0, 0, At, B0); PG8_MMA(0, 1, At, B1); PG8_BAR; PG8_SCHED;
            PG8_LDA(At, 0, 1); PG8_STAGE(PG8_SB(0, 0), b2, voffB); PG8_STAGE(PG8_SB(0, 1), b2 + hstepB, voffB); PG8_STAGE(PG8_SA(0, 0), a2, voffA);
            PG8_WAIT_V(8); PG8_WAIT_L(0); PG8_BAR; PG8_MMA(1, 0, At, B0); PG8_MMA(1, 1, At, B1); PG8_BAR; PG8_SCHED;
            PG8_LDB(B0, 1, 0); PG8_LDB(B1, 1, 1); PG8_SCHED; PG8_LDA(At, 1, 0); PG8_STAGE(PG8_SA(0, 1), a2 + hstepA, voffA);
            PG8_WAIT_V(8); PG8_WAIT_L(0); PG8_BAR; PG8_MMA(0, 0, At, B0); PG8_MMA(0, 1, At, B1); PG8_BAR; PG8_SCHED;
            PG8_LDA(At, 1, 1); PG8_STAGE(PG8_SB(1, 0), b3, voffB); PG8_STAGE(PG8_SB(1, 1), b3 + hstepB, voffB); PG8_STAGE(PG8_SA(1, 0), a3, voffA);
            PG8_WAIT_V(8); PG8_WAIT_L(0); PG8_BAR; PG8_MMA(1, 0, At, B0); PG8_MMA(1, 1, At, B1); PG8_BAR; PG8_SCHED;
            } else {
            PG8_LDB(B0, 0, 0); PG8_SCHED; PG8_LDA(At, 0, 0); PG8_STAGE(PG8_SA(1, 1), a1 + hstepA, voffA);
            PG8_WAIT_L(8); PG8_BAR; PG8_WAIT_L(0); PG8_MMA(0, 0, At, B0); PG8_BAR; PG8_SCHED;
            PG8_LDB(B1, 0, 1); PG8_STAGE(PG8_SB(0, 0), b2, voffB);
            PG8_BAR; PG8_WAIT_L(0); PG8_MMA(0, 1, At, B1); PG8_BAR;
            PG8_LDA(At, 0, 1); PG8_STAGE(PG8_SA(0, 0), a2, voffA);
            PG8_BAR; PG8_WAIT_L(0); PG8_MMA(1, 0, At, B0); PG8_BAR; PG8_SCHED;
            PG8_STAGE(PG8_SB(0, 1), b2 + hstepB, voffB);
            PG8_WAIT_V(6); PG8_BAR; PG8_MMA(1, 1, At, B1); PG8_BAR;
            PG8_LDB(B0, 1, 0); PG8_SCHED; PG8_LDA(At, 1, 0); PG8_STAGE(PG8_SA(0, 1), a2 + hstepA, voffA);
            PG8_WAIT_L(8); PG8_BAR; PG8_WAIT_L(0); PG8_MMA(0, 0, At, B0); PG8_BAR; PG8_SCHED;
            PG8_LDB(B1, 1, 1); PG8_STAGE(PG8_SB(1, 0), b3, voffB);
            PG8_BAR; PG8_WAIT_L(0); PG8_MMA(0, 1, At, B1); PG8_BAR;
            PG8_LDA(At, 1, 1); PG8_STAGE(PG8_SA(1, 0), a3, voffA);
            PG8_BAR; PG8_WAIT_L(0); PG8_MMA(1, 0, At, B0); PG8_BAR; PG8_SCHED;
            PG8_STAGE(PG8_SB(1, 1), b3 + hstepB, voffB);
            PG8_WAIT_V(6); PG8_BAR; PG8_MMA(1, 1, At, B1); PG8_BAR;
            }
        }
        if constexpr (ALIGN_EPI) { if (wr == 0) PG8_BAR; }
        if constexpr (!Epi::AFTER_DRAIN) { E(acc, cur, wr, wc, fr, fq); S.done(cur); }
        if (!has_next) break;
        if ((Epi::CHAIN || !SP2) && (!Epi::CHAIN || cur.kb == 2)) {
#pragma unroll
        for (int a = 0; a < 2; ++a)
#pragma unroll
            for (int b = 0; b < 2; ++b)
#pragma unroll
                for (int m = 0; m < 4; ++m)
#pragma unroll
                    for (int n = 0; n < 2; ++n) acc[a][b][m][n] = (f32x4){0.f, 0.f, 0.f, 0.f};
        }
        cur = nxt; cA = nA; cB = nB; ++ui;
        if constexpr (ALIGN_EPI) { if (wr == 1) PG8_BAR; }
    }
    if (has_link) { if constexpr (ALIGN_EPI) { if (wr == 1) PG8_BAR; } return; }
    PG8_WAIT_V(0);
    if constexpr (!ALIGN_EPI) { if (wr == 0) PG8_BAR; }
    PG8_BAR;
    if constexpr (Epi::AFTER_DRAIN) { E.fused(acc, cur, wr, wc, fr, fq, lds, wid, lane); S.done(cur); }
#undef PG8_SA
#undef PG8_SB
#undef PG8_STAGE
#undef PG8_LDA
#undef PG8_LDB
#undef PG8_MMA
#undef PG8_MMA0
#undef PG8_WAIT_V
#undef PG8_WAIT_L
#undef PG8_BAR
#undef PG8_SCHED
}
}


constexpr int DM = 2048, DIN = 6144, DFF = 5632, DEPTH = 4;
constexpr int MP = 16384, NSB = 32, LSQ = 32, M = MP + NSB * LSQ;
constexpr int WM = 1024;
constexpr int OFF_BG = 0, OFF_CG = 1024, OFF_HC = 2048, OFF_US = 3072, OFF_UG = 4096, OFF_VG = 5120;
constexpr int QMODE = 2;
constexpr int NB16 = QMODE == 0 ? 16 : QMODE == 1 ? 12 : 8, NH8 = 24 - NB16;
__host__ __device__ constexpr int h_tile16(int i) { return QMODE == 0 ? ((i >= 12 && i < 16) ? i + 4 : (i >= 16 && i < 20) ? i - 4 : i) : QMODE == 1 ? i : (i < 8 ? i + 4 : i < 12 ? i - 8 : i); }
__host__ __device__ constexpr int h_tile8(int j) { return h_tile16(NB16 + j); }
constexpr int SG = 64, SP = 64, SI = 16, CH = 32, NCH = MP / CH;
constexpr float EPS = 1e-6f;
constexpr int NWAVES = 8, NTHREADS = NWAVES * 64;

constexpr size_t O_Y = 0;
constexpr size_t O_CONVP = (size_t)M * DM;
constexpr size_t O_SREP = O_CONVP + 4 * 2 * 1024;
constexpr size_t O_SIMP = O_SREP + 4 * 64 * 64;
constexpr size_t O_CONVS = O_SIMP + 4 * 64 * 64;
constexpr size_t O_SRES = O_CONVS + 4 * 32 * 2 * 1024;
constexpr size_t O_SIMS = O_SRES + 4 * 32 * 64 * 64;
constexpr size_t O_VS = O_SIMS + 4 * 32 * 64 * 64;
constexpr size_t O_END = O_VS + (size_t)4 * 32 * 32 * 1024;
static_assert(O_END == 41197568, "output size");

constexpr size_t MiB = 1u << 20;
constexpr size_t WS_CTL = 0, CTL_ZERO_BYTES = 1 * MiB;
constexpr size_t WS_SSMC = 1 * MiB;
constexpr size_t SSMC_LAYER = 576 * 1024, SSMC_LB = 0, SSMC_LBT = 32 * 1024, SSMC_BB = 64 * 1024;
constexpr size_t WS_SSQ = 4 * MiB;
constexpr size_t WS_RSTD = 7 * MiB;
constexpr size_t WS_S8 = 8 * MiB;
constexpr size_t WS_XB = 15 * MiB;
constexpr size_t WS_H = 83 * MiB;
constexpr size_t WS_G = 287 * MiB;
constexpr size_t WS_Y3 = 491 * MiB;
constexpr size_t WS_YS = 593 * MiB, WS_VN = 627 * MiB;
constexpr int Y3W = 3 * WM;
constexpr size_t WS_MG = 661 * MiB;
constexpr size_t WS_XB8 = WS_MG;
constexpr float W8_SCALE = 1408.0f;
constexpr float X8_SCALE = 28.0f;
constexpr size_t WS_E2 = WS_MG;
constexpr size_t WS_W = 729 * MiB, W_LAYER = 136 * MiB;
constexpr size_t W_1 = 0, W_1G = 24 * MiB  , W_M = 48 * MiB  , W_GLU = 60 * MiB, W_O = 62 * MiB, W_F1 = 70 * MiB, W_F2 = 114 * MiB;
constexpr size_t WS_TAB = WS_W + 4 * W_LAYER, TAB_LAYER = 2 * MiB;
constexpr size_t T_BBT = 0, T_CMT = 256 * 1024, T_LPOW = 512 * 1024, T_WSB = 1024 * 1024;
constexpr size_t WS_END = WS_TAB + 4 * TAB_LAYER;
static_assert((size_t)M * DM * 2 == 68 * MiB && (size_t)M * DIN * 2 == 204 * MiB && (size_t)M * WM * 2 == 34 * MiB, "ws map");
static_assert((size_t)M * DFF * 2 <= 204 * MiB && (size_t)M * DM * 4 <= 204 * MiB && (size_t)DFF * DM * 2 == 22 * MiB, "ws map");

constexpr int LDS_BYTES = 147456;
constexpr int RING_BYTES = 131072, MISC_OFF = LDS_BYTES - 256;

enum { I_XP = 0, I_XS, I_CACHE, I_STRE, I_STIM, I_NMIX, I_WIN, I_CONVW, I_WCO, I_LRE, I_LIM, I_LDT, I_BRE, I_BIM, I_CRE, I_CIM, I_SD, I_WGLU, I_BGLU, I_WSO, I_LNV, I_WS, I_BS, I_WGO, I_WGATE, I_BGATE, I_WO, I_NFFN, I_WF1, I_WF2, I_NFIN, N_IN };

#define LAS __attribute__((address_space(3)))
typedef unsigned short bf16;
typedef unsigned v4u __attribute__((ext_vector_type(4)));
typedef unsigned v2u __attribute__((ext_vector_type(2)));
typedef float f32x4 __attribute__((ext_vector_type(4)));
typedef float f32x2 __attribute__((ext_vector_type(2)));
typedef short bf16x8 __attribute__((ext_vector_type(8)));
typedef float f32x16 __attribute__((ext_vector_type(16)));
#define MFMA32(a, b, c) __builtin_amdgcn_mfma_f32_32x32x16_bf16((a), (b), (c), 0, 0, 0)
#define MFMA16(a, b, c) __builtin_amdgcn_mfma_f32_16x16x32_bf16((a), (b), (c), 0, 0, 0)
#define LDS_WAIT() asm volatile("s_waitcnt lgkmcnt(0)" ::: "memory")
#define GAS __attribute__((address_space(1)))
#define LAUNDER_G(p, c) do { GAS unsigned char* g_ = (GAS unsigned char*)(p); asm volatile("" : c(g_)); (p) = (__typeof__((p) + 0))(unsigned char*)g_; } while (0)
#define VM_WAIT() asm volatile("s_waitcnt vmcnt(0)" ::: "memory")

typedef __bf16 bf16x2_t __attribute__((ext_vector_type(2)));
__device__ __forceinline__ unsigned cvt_pk(float lo, float hi) { const f32x2 f = {lo, hi}; return __builtin_bit_cast(unsigned, __builtin_convertvector(f, bf16x2_t)); }
__device__ __forceinline__ float bflo(unsigned w) { return __uint_as_float(w << 16); }
__device__ __forceinline__ float bfhi(unsigned w) { return __uint_as_float(w & 0xffff0000u); }
__device__ __forceinline__ void unpack8(const v4u w, float (&f)[8]) { f[0] = bflo(w.x); f[1] = bfhi(w.x); f[2] = bflo(w.y); f[3] = bfhi(w.y); f[4] = bflo(w.z); f[5] = bfhi(w.z); f[6] = bflo(w.w); f[7] = bfhi(w.w); }
__device__ __forceinline__ v4u pack8(const float (&f)[8]) { v4u w; w.x = cvt_pk(f[0], f[1]); w.y = cvt_pk(f[2], f[3]); w.z = cvt_pk(f[4], f[5]); w.w = cvt_pk(f[6], f[7]); return w; }
__device__ __forceinline__ unsigned q8b(float x, float sc) { const float m = 12582912.0f; return __float_as_uint(__builtin_amdgcn_fmed3f(__builtin_fmaf(x, sc, m), m - 127.0f, m + 127.0f)); }
__device__ __forceinline__ unsigned pack4_i8(float a, float b, float c, float d, float sc) {
    const unsigned w01 = __builtin_amdgcn_perm(q8b(b, sc), q8b(a, sc), 0x0c0c0400u), w23 = __builtin_amdgcn_perm(q8b(d, sc), q8b(c, sc), 0x0c0c0400u); return w01 | (w23 << 16); }
__device__ __forceinline__ float sigmoid_f(float v) { return __builtin_amdgcn_rcpf(1.0f + __builtin_amdgcn_exp2f(-1.44269504f * v)); }
__device__ __forceinline__ float gelu_t(float x) { return x * sigmoid_f(1.5957691216f * x * (1.0f + 0.044715f * x * x)); }
__device__ __forceinline__ float wave_sum(float v) {
#pragma unroll
    for (int o = 1; o < 64; o <<= 1) v += __shfl_xor(v, o);
    return v;
}

__device__ __forceinline__ int lane_id_opaque() { unsigned z = 0u; asm volatile("" : "+s"(z)); return (int)__builtin_amdgcn_mbcnt_hi(~0u, __builtin_amdgcn_mbcnt_lo(~0u, z)); }
#define XB_TMO      128
#define XB_XCNT(j)  (256  + 64 * (j))
#define XB_XSUB(j)  (1280 + 64 * (j))
#define XB_XGEN(j)  (2304 + 64 * (j))
#define XB_TOP      3328
#define XB_TOPGEN   3392
#define XCD_BAR_WORDS 3456
#define XB_SPIN_CAP (1u << 22)

__device__ __forceinline__ unsigned xb_ld(unsigned* p)              { return __hip_atomic_load(p, __ATOMIC_RELAXED, __HIP_MEMORY_SCOPE_AGENT); }
__device__ __forceinline__ unsigned xb_add(unsigned* p, unsigned v) { return __hip_atomic_fetch_add(p, v, __ATOMIC_RELAXED, __HIP_MEMORY_SCOPE_AGENT); }
__device__ __forceinline__ unsigned xb_xcc_id() { return (unsigned)__builtin_amdgcn_s_getreg((3 << 11) | 20) & 0xFu; }
#define XB_SPIN(cond, bar) do { unsigned _sp = 0; while (cond) { __builtin_amdgcn_s_sleep(1); \
    if ((++_sp & 255u) == 0u) { if (xb_ld(&(bar)[XB_TMO])) break; if (_sp > XB_SPIN_CAP) { atomicAdd(&(bar)[XB_TMO], 1u); break; } } } } while (0)

struct XcdBarrier { unsigned* bar; unsigned x; volatile LAS unsigned* st; unsigned wave; };

__device__ __forceinline__ XcdBarrier xcd_barrier_post(unsigned* bar, volatile LAS unsigned* st, unsigned wave) {
    XcdBarrier b; b.bar = bar; b.x = xb_xcc_id(); b.st = st; b.wave = wave;
    if (wave == 0u && lane_id_opaque() == 0) (void)xb_add(&bar[XB_XCNT(b.x)], 1u);
    return b;
}
__device__ __forceinline__ void xcd_barrier_complete(unsigned* bar, unsigned x, unsigned& nloc, unsigned& nx) {
    const unsigned G = gridDim.x * gridDim.y * gridDim.z;
    unsigned sum, cnt, mine, sp = 0u;
    for (;;) {
        sum = 0u; cnt = 0u; mine = 0u;
#pragma unroll
        for (unsigned j = 0; j < 16; ++j) { const unsigned c = xb_ld(&bar[XB_XCNT(j)]); sum += c; cnt += (c > 0u) ? 1u : 0u; mine = (j == x) ? c : mine; }
        if (sum == G) break;
        __builtin_amdgcn_s_sleep(1);
        if ((++sp & 255u) == 0u) { if (xb_ld(&bar[XB_TMO])) break; if (sp > XB_SPIN_CAP) { atomicAdd(&bar[XB_TMO], 1u); break; } }
    }
    nloc = mine > 0u ? mine : 1u; nx = cnt > 0u ? cnt : 1u;
}
__device__ __forceinline__ void xcd_barrier(const XcdBarrier& b) {
    asm volatile("s_waitcnt vmcnt(0)" ::: "memory");
    __syncthreads();
    if (b.wave == 0u && lane_id_opaque() == 0) {
        unsigned* bar = b.bar; unsigned bx = b.x; LAUNDER_G(bar, "+s"); asm volatile("" : "+s"(bx));
        __builtin_amdgcn_s_waitcnt(0);
        unsigned nloc = b.st[0], nx = b.st[1];
        if (nloc == 0u) { xcd_barrier_complete(bar, bx, nloc, nx); b.st[0] = nloc; b.st[1] = nx; }
        const unsigned old = xb_add(&bar[XB_XSUB(bx)], 1u);
        const unsigned gen = old / nloc;
        if (old + 1u == (gen + 1u) * nloc) {
            __builtin_amdgcn_fence(__ATOMIC_RELEASE, "agent");
            asm volatile("s_waitcnt vmcnt(0)" ::: "memory");
            const unsigned og = xb_add(&bar[XB_TOP], 1u);
            const unsigned tg = og / nx;
            if (og + 1u == (tg + 1u) * nx) xb_add(&bar[XB_TOPGEN], 1u);
            else XB_SPIN(xb_ld(&bar[XB_TOPGEN]) == tg, bar);
            __builtin_amdgcn_fence(__ATOMIC_ACQUIRE, "agent");
            xb_add(&bar[XB_XGEN(bx)], 1u);
            asm volatile("s_waitcnt vmcnt(0)" ::: "memory");
        } else {
            XB_SPIN(xb_ld(&bar[XB_XGEN(bx)]) == gen, bar);
            __builtin_amdgcn_fence(__ATOMIC_ACQUIRE, "agent");
            asm volatile("s_waitcnt vmcnt(0)" ::: "memory");
        }
    }
    __syncthreads();
}

struct Frame {
    LAS unsigned char* lds;
    int tid, lane, wave, vcu, G;
    float* out;
    unsigned char* ws;
};
#define WSP(T, off) ((T*)(F.ws + (off)))
#define SITE(Fs) Frame F = Fs; LAUNDER_G(F.ws, "+s"); LAUNDER_G(F.out, "+s"); asm volatile("" : "+s"(F.wave)); F.lane = lane_id_opaque(); F.tid = F.wave * 64 + F.lane
struct Args { const float* in[N_IN]; float* out; unsigned char* ws; int ph_lo, ph_hi; };
static_assert(sizeof(Args) == N_IN * 8 + 24, "Args has no padding");
typedef const __attribute__((address_space(4))) Args KArgs;
#define KARGS() KArgs* kargs = (KArgs*)__builtin_amdgcn_kernarg_segment_ptr(); asm volatile("" : "+s"(kargs))
#define INP(i) (kargs->in[i])

using pg8::Unit;
typedef pg8::f32x4 A4;

__device__ __forceinline__ void row_rstd(const float* ssq, int row0, int fq, float (&rs)[2][4], const float* rstd = nullptr) {
    if (rstd) {
#pragma unroll
        for (int ai = 0; ai < 2; ++ai)
#pragma unroll
            for (int m = 0; m < 4; ++m) rs[ai][m] = rstd[row0 + ai * 128 + m * 16];
        return; }
#pragma unroll
    for (int ai = 0; ai < 2; ++ai)
#pragma unroll
        for (int m = 0; m < 4; ++m) {
            const f32x4* p = (const f32x4*)(ssq + (size_t)(row0 + ai * 128 + m * 16) * 32 + fq * 8);
            const f32x4 a = p[0], b = p[1];
            float s = ((a.x + a.y) + (a.z + a.w)) + ((b.x + b.y) + (b.z + b.w));
            s += __shfl_xor(s, 16); s += __shfl_xor(s, 32);
            rs[ai][m] = rsqrtf(s * (1.0f / DM) + EPS);
        }
}

struct EpiH {
    static constexpr bool PERM = true, AFTER_DRAIN = false, CHAIN = false;
    bf16* H; const float* ssq; const float* rstd;
    __device__ __forceinline__ void operator()(const A4 (&acc)[2][2][4][2], const Unit& u, int wr, int wc, int fr, int fq) const {
        const int row0 = u.pm * 256 + wr * 64 + fr;
        float rs[2][4]; row_rstd(ssq, row0, fq, rs, u.pm < MP / 256 ? rstd : nullptr);
        const int ht = h_tile16(u.pn); const bool zt = ht >= OFF_CG / 256 && ht < OFF_US / 256;
        const int colt = ht * 256 + wc * 32 + 8 * fq;
#pragma unroll
        for (int ai = 0; ai < 2; ++ai)
#pragma unroll
            for (int m = 0; m < 4; ++m) {
                const float r = rs[ai][m];
                if (zt) {
                    float f[8];
#pragma unroll
                    for (int n = 0; n < 2; ++n)
#pragma unroll
                        for (int j = 0; j < 4; ++j) f[4 * n + j] = (acc[ai][0][m][n][j] * r) * (acc[ai][1][m][n][j] * r);
                    *(v4u*)(H + (size_t)(row0 + ai * 128 + m * 16) * DIN + OFF_CG + 128 * (ht - OFF_CG / 256) + wc * 32 + 8 * fq) = pack8(f);
                } else {
                    bf16* rowp = H + (size_t)(row0 + ai * 128 + m * 16) * DIN + colt;
#pragma unroll
                    for (int bj = 0; bj < 2; ++bj) {
                        float f[8];
#pragma unroll
                        for (int n = 0; n < 2; ++n)
#pragma unroll
                            for (int j = 0; j < 4; ++j) f[4 * n + j] = acc[ai][bj][m][n][j] * r;
                        *(v4u*)(rowp + bj * 128) = pack8(f);
                    }
                }
            }
    }
};
struct EpiG8 {
    static constexpr bool PERM = true, AFTER_DRAIN = false, CHAIN = false;
    bf16* H; bf16* Gt; const float* ssq; const float* bgate; const float* rstd; const float* s8;
    __device__ __forceinline__ void operator()(const A4 (&acc)[2][2][4][2], const Unit& u, int wr, int wc, int fr, int fq) const {
        { const int ln = lane_id_opaque(); fr = ln & 15; fq = ln >> 4; }
        const int row0 = u.pm * 256 + wr * 64 + fr;
        float rs[2][4]; row_rstd(ssq, row0, fq, rs, u.pm < MP / 256 ? rstd : nullptr);
#pragma unroll
        for (int ai = 0; ai < 2; ++ai)
#pragma unroll
            for (int m = 0; m < 4; ++m) rs[ai][m] *= (1.0f / W8_SCALE) * __builtin_amdgcn_rcpf(s8[row0 + ai * 128 + m * 16]);
        if (u.pn < NH8) {
            const int colt = h_tile8(u.pn) * 256 + wc * 32 + 8 * fq;
#pragma unroll
            for (int ai = 0; ai < 2; ++ai)
#pragma unroll
                for (int m = 0; m < 4; ++m) {
                    const float r = rs[ai][m]; bf16* rowp = H + (size_t)(row0 + ai * 128 + m * 16) * DIN + colt;
#pragma unroll
                    for (int bj = 0; bj < 2; ++bj) {
                        float f[8];
#pragma unroll
                        for (int n = 0; n < 2; ++n)
#pragma unroll
                            for (int j = 0; j < 4; ++j) f[4 * n + j] = (float)__float_as_int(acc[ai][bj][m][n][j]) * r;
                        *(v4u*)(rowp + bj * 128) = pack8(f);
                    }
                }
            return;
        }
        const int gn = u.pn - NH8, tid = (wr * 4 + wc) * 64 + fq * 16 + fr, colt = gn * 256 + wc * 32 + 8 * fq;
        f32x4 bv[2][2];
#pragma unroll
        for (int bj = 0; bj < 2; ++bj)
#pragma unroll
            for (int n = 0; n < 2; ++n) bv[bj][n] = *(const f32x4*)(bgate + colt + bj * 128 + 4 * n) * -1.44269504f - 8.0f;
#pragma unroll
        for (int ai = 0; ai < 2; ++ai)
#pragma unroll
            for (int m = 0; m < 4; ++m) {
                const float r = rs[ai][m] * -1.44269504f;
                unsigned q[4] = {0u, 0u, 0u, 0u};
#pragma unroll
                for (int bj = 0; bj < 2; ++bj)
#pragma unroll
                    for (int n = 0; n < 2; ++n) {
                        unsigned w = 0u;
#pragma unroll
                        for (int j = 0; j < 4; ++j) w = __builtin_amdgcn_cvt_pk_u8_f32(floorf(__builtin_amdgcn_rcpf(__builtin_amdgcn_exp2f(__builtin_fmaf((float)__float_as_int(acc[ai][bj][m][n][j]), r, bv[bj][n][j])) + 0.00390625f)), j, w);
                        q[2 * bj + n] = w;
                    }
                *(v4u*)((unsigned char*)Gt + ((size_t)(u.pm * 24 + gn) * 8 + ai * 4 + m) * 8192 + (size_t)tid * 16) = (v4u){q[0], q[1], q[2], q[3]};
            }
    }
};
__device__ __forceinline__ const v4u* gt_ptr(const bf16* Gt, int pm, int gn, int ai, int m, int tid) { return (const v4u*)((const unsigned char*)Gt + ((size_t)(pm * 24 + gn) * 8 + ai * 4 + m) * 8192 + (size_t)tid * 16); }
__device__ __forceinline__ void gate_unpack(const v4u w, float (&g)[2][8]) {
    const unsigned q[4] = {w.x, w.y, w.z, w.w};
#pragma unroll
    for (int i = 0; i < 4; ++i)
#pragma unroll
        for (int b = 0; b < 4; ++b) g[i >> 1][4 * (i & 1) + b] = ((float)((q[i] >> (8 * b)) & 0xffu) + 0.5f) * (1.0f / 256.0f);
}
constexpr size_t SLAB = 65536;
struct EpiGLU {
    static constexpr bool PERM = true, AFTER_DRAIN = false, CHAIN = false;
    const bf16* YS; bf16* YS2; const float* bias; const bf16* slab;
    __device__ __forceinline__ void group(const A4 (&a)[2][2], const f32x4 (&bv)[2][2], int row, int col0) const {
#pragma unroll
        for (int bj = 0; bj < 2; ++bj) {
            float y[8], f[8]; unpack8(*(const v4u*)(YS + (size_t)row * WM + col0 + bj * 128), y);
#pragma unroll
            for (int n = 0; n < 2; ++n)
#pragma unroll
                for (int j = 0; j < 4; ++j) f[4 * n + j] = y[4 * n + j] * sigmoid_f(a[bj][n][j] + bv[bj][n][j]);
            *(v4u*)(YS2 + (size_t)row * Y3W + col0 + bj * 128) = pack8(f);
        }
    }
    __device__ __forceinline__ void operator()(const A4 (&acc)[2][2][4][2], const Unit& u, int wr, int wc, int fr, int fq) const {
        { const int ln = lane_id_opaque(); fr = ln & 15; fq = ln >> 4; }
        const int row0 = u.pm * 256 + wr * 64 + fr, col0 = u.pn * 256 + wc * 32 + 8 * fq;
        f32x4 bv[2][2];
#pragma unroll
        for (int bj = 0; bj < 2; ++bj)
#pragma unroll
            for (int n = 0; n < 2; ++n) bv[bj][n] = *(const f32x4*)(bias + col0 + bj * 128 + 4 * n);
#pragma unroll
        for (int ai = 0; ai < 2; ++ai)
#pragma unroll
            for (int m = 0; m < 4; ++m) {
                const A4 a[2][2] = {{acc[ai][0][m][0], acc[ai][0][m][1]}, {acc[ai][1][m][0], acc[ai][1][m][1]}};
                group(a, bv, row0 + ai * 128 + m * 16, col0);
                asm volatile("" ::: "memory");
            }
    }
    __device__ __forceinline__ void reduce(int ts, int grp, int tid) const {
        asm volatile("" : "+v"(tid));
        const int wid = tid >> 6, lane = tid & 63, wr = wid >> 2, wc = wid & 3, fr = lane & 15, fq = lane >> 4, ai = grp >> 2, m = grp & 3;
        const int row = (MP / 256 + (ts >> 2)) * 256 + ai * 128 + wr * 64 + m * 16 + fr, col0 = (ts & 3) * 256 + wc * 32 + 8 * fq;
        A4 a[2][2]; f32x4 bv[2][2];
#pragma unroll
        for (int bj = 0; bj < 2; ++bj) { const bf16* p = slab + (size_t)(ts * 4) * SLAB + (size_t)(grp * 2 + bj) * 4096 + (size_t)tid * 8; float t[8]; unpack8(*(const v4u*)p, t);
#pragma unroll
            for (int sl = 1; sl < 4; ++sl) { p += SLAB; LAUNDER_G(p, "+v"); float x[8]; unpack8(*(const v4u*)p, x);
#pragma unroll
                for (int j = 0; j < 8; ++j) t[j] += x[j]; }
            a[bj][0] = (A4){t[0], t[1], t[2], t[3]}; a[bj][1] = (A4){t[4], t[5], t[6], t[7]};
            bv[bj][0] = *(const f32x4*)(bias + col0 + bj * 128); bv[bj][1] = *(const f32x4*)(bias + col0 + bj * 128 + 4); }
        group(a, bv, row, col0);
    }
};
__device__ __forceinline__ void store_slab(const A4 (&acc)[2][2][4][2], bf16* slab, int tid) {
    bf16* p = slab + (size_t)tid * 8;
#pragma unroll
    for (int ai = 0; ai < 2; ++ai)
#pragma unroll
        for (int m = 0; m < 4; ++m)
#pragma unroll
            for (int bj = 0; bj < 2; ++bj) { const float f[8] = {acc[ai][bj][m][0][0], acc[ai][bj][m][0][1], acc[ai][bj][m][0][2], acc[ai][bj][m][0][3], acc[ai][bj][m][1][0], acc[ai][bj][m][1][1], acc[ai][bj][m][1][2], acc[ai][bj][m][1][3]};
                *(v4u*)p = pack8(f); p += 4096; LAUNDER_G(p, "+v"); }
}
struct EpiSlab {
    static constexpr bool PERM = true, AFTER_DRAIN = false, CHAIN = false;
    bf16* slab; int per, npn;
    __device__ __forceinline__ void operator()(const A4 (&acc)[2][2][4][2], const Unit& u, int wr, int wc, int fr, int fq) const {
        store_slab(acc, slab + (size_t)((((u.pm - MP / 256) * npn + u.pn) * per) + u.part) * SLAB, (wr * 4 + wc) * 64 + fq * 16 + fr); }
};
struct EpiMrgC {
    static constexpr bool PERM = true, AFTER_DRAIN = false, CHAIN = true;
    const bf16* Gt; bf16* MG; bf16* slab;
    __device__ __forceinline__ void operator()(A4 (&acc)[2][2][4][2], const Unit& u, int wr, int wc, int fr, int fq) const {
        const int row0 = u.pm * 256 + wr * 64 + fr, col0 = u.pn * 256 + wc * 32 + 8 * fq, tid = (wr * 4 + wc) * 64 + fq * 16 + fr;
        const __amdgpu_buffer_rsrc_t rs = __builtin_amdgcn_make_buffer_rsrc((void*)Gt, (short)0, 0x7fffffff, 0x00020000);
        const int vo = tid * 16, so = ((u.pm * 24 + u.kb * 8 + u.pn) * 8) * 8192;
#pragma unroll
        for (int ai = 0; ai < 2; ++ai) {
            v4u gw[4], gnw[4];
#pragma unroll
            for (int m = 0; m < 4; ++m) gw[m] = __builtin_bit_cast(v4u, __builtin_amdgcn_raw_buffer_load_b128(rs, vo, so + (ai * 4 + m) * 8192, 0));
            if (u.kb < 2) {
#pragma unroll
                for (int m = 0; m < 4; ++m) gnw[m] = __builtin_bit_cast(v4u, __builtin_amdgcn_raw_buffer_load_b128(rs, vo, so + (64 + ai * 4 + m) * 8192, 0));
#pragma unroll
                for (int m = 0; m < 4; ++m) {
                    const unsigned q[4] = {gw[m].x, gw[m].y, gw[m].z, gw[m].w}, qn[4] = {gnw[m].x, gnw[m].y, gnw[m].z, gnw[m].w};
#pragma unroll
                    for (int i = 0; i < 4; ++i)
#pragma unroll
                        for (int b = 0; b < 4; ++b) acc[ai][i >> 1][m][i & 1][b] *= ((float)((q[i] >> (8 * b)) & 0xffu) + 0.5f) * __builtin_amdgcn_rcpf((float)((qn[i] >> (8 * b)) & 0xffu) + 0.5f);
                }
            } else {
#pragma unroll
                for (int m = 0; m < 4; ++m) {
                    const int row = row0 + ai * 128 + m * 16;
                    float g[2][8]; gate_unpack(gw[m], g);
#pragma unroll
                    for (int bj = 0; bj < 2; ++bj) {
                        float f[8];
#pragma unroll
                        for (int j = 0; j < 4; ++j) { f[j] = g[bj][j] * acc[ai][bj][m][0][j]; f[4 + j] = g[bj][4 + j] * acc[ai][bj][m][1][j]; }
                        *(v4u*)(MG + (size_t)row * DM + col0 + bj * 128) = pack8(f);
                    }
                }
            }
            asm volatile("" ::: "memory");
        }
    }
    __device__ __forceinline__ void reduce(int ts, int grp, int tid) const {
        asm volatile("" : "+v"(tid));
        const int wid = tid >> 6, lane = tid & 63, wr = wid >> 2, wc = wid & 3, fr = lane & 15, fq = lane >> 4, ai = grp >> 2, m = grp & 3;
        const int row = (MP / 256 + (ts >> 3)) * 256 + ai * 128 + wr * 64 + m * 16 + fr, col0 = (ts & 7) * 256 + wc * 32 + 8 * fq;
        float g[3][2][8];
#pragma unroll
        for (int b = 0; b < 3; ++b) gate_unpack(*gt_ptr(Gt, MP / 256 + (ts >> 3), b * 8 + (ts & 7), ai, m, tid), g[b]);
#pragma unroll
        for (int bj = 0; bj < 2; ++bj) {
            float f[8];
#pragma unroll
            for (int j = 0; j < 8; ++j) f[j] = 0.f;
#pragma unroll
            for (int b = 0; b < 3; ++b) {
                { const size_t off = (size_t)(grp * 2 + bj) * 4096 + (size_t)tid * 8; float p0[8], p1[8];
                    unpack8(*(const v4u*)(slab + (size_t)(ts * 6 + 2 * b) * SLAB + off), p0); unpack8(*(const v4u*)(slab + (size_t)(ts * 6 + 2 * b + 1) * SLAB + off), p1);
#pragma unroll
                    for (int j = 0; j < 8; ++j) f[j] += g[b][bj][j] * (p0[j] + p1[j]); }
            }
            *(v4u*)(MG + (size_t)row * DM + col0 + bj * 128) = pack8(f);
        }
    }
};
template <int MODE> struct EpiRes {
    static constexpr bool PERM = true, AFTER_DRAIN = false, CHAIN = false;
    float* X; bf16* XB; float* ssq; bf16* slab; int dry;
    const float* XinP; const float* XinS; int first;
    unsigned char* XB8; const float* s8;
    __device__ __forceinline__ void xload(A4 (&x)[2][2], int row, int col0) const {
        if (MODE == 0 && first) { const float* xi = (row < MP ? XinP : XinS) + (size_t)row * DM + col0;
#pragma unroll
            for (int bj = 0; bj < 2; ++bj) { x[bj][0] = *(const f32x4*)(xi + bj * 128); x[bj][1] = *(const f32x4*)(xi + bj * 128 + 4); }
        } else {
#pragma unroll
            for (int bj = 0; bj < 2; ++bj) { float t[8]; unpack8(*(const v4u*)(XB + (size_t)row * DM + col0 + bj * 128), t); x[bj][0] = (A4){t[0], t[1], t[2], t[3]}; x[bj][1] = (A4){t[4], t[5], t[6], t[7]}; } }
    }
    __device__ __forceinline__ void group(const A4 (&a)[2][2], const A4 (&x)[2][2], int row, int col0, int pn, int wc, int fq, float sc = 0.f) const {
        float s = 0.f;
#pragma unroll
        for (int bj = 0; bj < 2; ++bj) {
            float f[8];
#pragma unroll
            for (int j = 0; j < 4; ++j) { f[j] = x[bj][0][j] + a[bj][0][j]; f[4 + j] = x[bj][1][j] + a[bj][1][j]; }
#pragma unroll
            for (int j = 0; j < 8; ++j) s += f[j] * f[j];
            if (DUPMASK && dry) { asm volatile("" :: "v"(f[0]), "v"(f[7])); continue; }
            *(v4u*)(XB + (size_t)row * DM + col0 + bj * 128) = pack8(f);
            if (MODE == 1) *(v2u*)(XB8 + (size_t)row * DM + col0 + bj * 128) = (v2u){pack4_i8(f[0], f[1], f[2], f[3], sc), pack4_i8(f[4], f[5], f[6], f[7], sc)};
        }
        s += __shfl_xor(s, 16); s += __shfl_xor(s, 32);
        if (fq == 0 && !(DUPMASK && dry)) ssq[(size_t)row * 32 + pn * 4 + wc] = s;
    }
    __device__ __forceinline__ void operator()(const A4 (&acc)[2][2][4][2], const Unit& u, int wr, int wc, int fr, int fq) const {
        const int row0 = u.pm * 256 + wr * 64 + fr, col0 = u.pn * 256 + wc * 32 + 8 * fq;
        A4 xq[2][2][2]; float sq[2] = {0.f, 0.f};
        xload(xq[0], row0, col0); if (MODE == 1) sq[0] = s8[row0];
#pragma unroll
        for (int k = 0; k < 8; ++k) {
            const int ai = k >> 2, m = k & 3;
            if (k < 7) { const int rn = row0 + ((k + 1) >> 2) * 128 + ((k + 1) & 3) * 16; xload(xq[(k + 1) & 1], rn, col0); if (MODE == 1) sq[(k + 1) & 1] = s8[rn]; }
            const A4 a[2][2] = {{acc[ai][0][m][0], acc[ai][0][m][1]}, {acc[ai][1][m][0], acc[ai][1][m][1]}};
            group(a, xq[k & 1], row0 + ai * 128 + m * 16, col0, u.pn, wc, fq, sq[k & 1]);
            asm volatile("" ::: "memory");
        }
    }
    __device__ __forceinline__ void reduce(int ts, int grp, int tid) const {
        asm volatile("" : "+v"(tid));
        const int wid = tid >> 6, lane = tid & 63, wr = wid >> 2, wc = wid & 3, fr = lane & 15, fq = lane >> 4, ai = grp >> 2, m = grp & 3;
        A4 a[2][2];
#pragma unroll
        for (int bj = 0; bj < 2; ++bj) { const bf16* p = slab + (size_t)(ts * 8) * SLAB + (size_t)(grp * 2 + bj) * 4096 + (size_t)tid * 8; float t[8]; unpack8(*(const v4u*)p, t);
#pragma unroll
            for (int sl = 1; sl < 8; ++sl) { p += SLAB; LAUNDER_G(p, "+v"); float x[8]; unpack8(*(const v4u*)p, x);
#pragma unroll
                for (int j = 0; j < 8; ++j) t[j] += x[j]; }
            a[bj][0] = (A4){t[0], t[1], t[2], t[3]}; a[bj][1] = (A4){t[4], t[5], t[6], t[7]}; }
        { const int row = (MP / 256 + (ts >> 3)) * 256 + ai * 128 + wr * 64 + m * 16 + fr, col0 = (ts & 7) * 256 + wc * 32 + 8 * fq; A4 x[2][2]; xload(x, row, col0); group(a, x, row, col0, ts & 7, wc, fq, MODE == 1 ? s8[row] : 0.f); }
    }
};
__device__ __forceinline__ void rstd_rows(const float* ssq, float* rstd, int b, int tid) {
    asm volatile("" : "+v"(tid));
    const int row = b * 64 + (tid >> 3), part = tid & 7;
    if (row < MP) { const f32x4 x = *(const f32x4*)(ssq + (size_t)row * 32 + part * 4); float s = (x.x + x.y) + (x.z + x.w);
        s += __shfl_xor(s, 1); s += __shfl_xor(s, 2); s += __shfl_xor(s, 4);
        if (part == 0) rstd[row] = rsqrtf(s * (1.0f / DM) + EPS); }
}
struct EpiFFN1 {
    static constexpr bool PERM = true, AFTER_DRAIN = false, CHAIN = false;
    bf16* FH; const float* ssq; const float* rstd; float* s8;
    __device__ __forceinline__ void operator()(const A4 (&acc)[2][2][4][2], const Unit& u, int wr, int wc, int fr, int fq) const {
        const int row0 = u.pm * 256 + wr * 64 + fr, col0 = u.pn * 128 + wc * 32 + 8 * fq;
        float rs[2][4]; row_rstd(ssq, row0, fq, rs, u.pm < MP / 256 ? rstd : nullptr);
        if (u.pn == 0 && wc == 0 && fq == 0) {
#pragma unroll
            for (int ai = 0; ai < 2; ++ai)
#pragma unroll
                for (int m = 0; m < 4; ++m) s8[row0 + ai * 128 + m * 16] = X8_SCALE * rs[ai][m]; }
#pragma unroll
        for (int ai = 0; ai < 2; ++ai)
#pragma unroll
            for (int m = 0; m < 4; ++m) {
                const float r = rs[ai][m], c1 = r * -1.44269504f, ir2 = __builtin_amdgcn_rcpf(r * r); float f[8];
#pragma unroll
                for (int n = 0; n < 2; ++n)
#pragma unroll
                    for (int j = 0; j < 4; ++j) { const float g = acc[ai][0][m][n][j], uu = acc[ai][1][m][n][j]; f[4 * n + j] = (g * uu) * __builtin_amdgcn_rcpf(__builtin_fmaf(__builtin_amdgcn_exp2f(g * c1), ir2, ir2)); }
                *(v4u*)(FH + (size_t)(row0 + ai * 128 + m * 16) * DFF + col0) = pack8(f);
            }
    }
};

struct CvItem { const float* W; const float* gain; bf16* WT; unsigned char* WT8; int ldw, src_n0, k0, ldt, dst_n0, dst8_n0; };
__device__ __forceinline__ void cv_load(const CvItem& I, f32x4 (&v)[16], f32x4 (&g)[2], int lane) {
    const int kq = lane >> 4, n4 = (lane & 15) * 4, c = lane & 7;
#pragma unroll
    for (int i = 0; i < 16; ++i) v[i] = __builtin_nontemporal_load((const f32x4*)(I.W + (size_t)(I.k0 + 4 * i + kq) * I.ldw + I.src_n0 + n4));
    if (I.gain) { g[0] = *(const f32x4*)(I.gain + I.k0 + 8 * c); g[1] = *(const f32x4*)(I.gain + I.k0 + 8 * c + 4); }
    else { g[0] = (f32x4){1.f, 1.f, 1.f, 1.f}; g[1] = g[0]; }
}
__device__ __forceinline__ void cv_store(const CvItem& I, const f32x4 (&v)[16], const f32x4 (&g)[2], LAS float* scr, int lane) {
    const int kq = lane >> 4, n4 = (lane & 15) * 4, c = lane & 7;
#pragma unroll
    for (int i = 0; i < 16; ++i) { LAS float* p = scr + (4 * i + kq) * 65 + n4; p[0] = v[i].x; p[1] = v[i].y; p[2] = v[i].z; p[3] = v[i].w; }
    LDS_WAIT();
#pragma unroll
    for (int j = 0; j < 8; ++j) { const int n = (lane >> 3) + 8 * j; const LAS float* sp = scr + (8 * c) * 65 + n;
        const float f[8] = {sp[0 * 65] * g[0].x, sp[1 * 65] * g[0].y, sp[2 * 65] * g[0].z, sp[3 * 65] * g[0].w, sp[4 * 65] * g[1].x, sp[5 * 65] * g[1].y, sp[6 * 65] * g[1].z, sp[7 * 65] * g[1].w};
        if (I.WT8) { v2u o; o.x = pack4_i8(f[0], f[1], f[2], f[3], W8_SCALE); o.y = pack4_i8(f[4], f[5], f[6], f[7], W8_SCALE); *(v2u*)(I.WT8 + (size_t)(I.dst8_n0 + n) * I.ldt + I.k0 + 8 * c) = o; }
        if (I.WT) *(v4u*)(I.WT + (size_t)(I.dst_n0 + n) * I.ldt + I.k0 + 8 * c) = pack8(f); }
    LDS_WAIT();
}
constexpr int IT_IN = 32 * 96, IT_GATE = 32 * 96, IT_CO = 16 * 32, IT_GLU = 16 * 16, IT_SO = 16 * 32, IT_GO = 16 * 32, IT_O = 32 * 32, IT_F1 = 32 * 176, IT_F2 = 88 * 32;
constexpr int IT_LAYER = IT_IN + IT_GATE + IT_CO + IT_GLU + IT_SO + IT_GO + IT_O + IT_F1 + IT_F2;
constexpr int BG_A = 4096, BG_B = BG_A + 6656, BG_C = BG_B + 3072;
__device__ __forceinline__ void cv_decode(KArgs* kargs, unsigned char* wl, int l, int r, CvItem& I) {
    I.gain = nullptr; I.WT8 = nullptr; I.dst8_n0 = 0;
    if (r < IT_IN)   { const int kb = r / 96, nb = r % 96, nd = 64 * nb, wt = nb >> 2;
                       I.W = INP(I_WIN) + (size_t)l * DM * DIN; I.ldw = DIN; I.k0 = 64 * kb; I.WT = (bf16*)(wl + W_1); I.ldt = DM; I.dst_n0 = nd; I.gain = INP(I_NMIX) + l * DM;
                       if (wt < NB16) { int src = h_tile16(wt) * 256 + (nd & 255);
                           if (src >= OFF_CG && src < OFF_US) { const int q = src - OFF_CG; src = (((q >> 7) & 1) ? OFF_HC : OFF_CG) + 128 * (q >> 8) + (q & 127); }
                           I.src_n0 = src; }
                       else { I.src_n0 = h_tile8(wt - NB16) * 256 + (nd & 255); I.WT8 = wl + W_1G; I.dst8_n0 = nd - NB16 * 256; }
                       return; } r -= IT_IN;
    if (r < IT_GATE) { const int kb = r / 96, nb = r % 96; I.W = INP(I_WGATE) + (size_t)l * DM * DIN; I.ldw = DIN; I.src_n0 = 64 * nb; I.k0 = 64 * kb; I.WT = nullptr; I.ldt = DM; I.dst_n0 = 0; I.gain = INP(I_NMIX) + l * DM;
                       I.WT8 = wl + W_1G; I.dst8_n0 = NH8 * 256 + 64 * nb; return; } r -= IT_GATE;
    if (r < IT_CO)   { const int kb = r / 32, nb = r % 32; I.W = INP(I_WCO) + (size_t)l * WM * DM; I.ldw = DM; I.src_n0 = 64 * nb; I.k0 = 64 * kb; I.WT = (bf16*)(wl + W_M); I.ldt = Y3W; I.dst_n0 = 64 * nb; return; } r -= IT_CO;
    if (r < IT_GLU)  { const int kb = r / 16, nb = r % 16; I.W = INP(I_WGLU) + (size_t)l * WM * WM; I.ldw = WM; I.src_n0 = 64 * nb; I.k0 = 64 * kb; I.WT = (bf16*)(wl + W_GLU); I.ldt = WM; I.dst_n0 = 64 * nb; return; } r -= IT_GLU;
    if (r < IT_SO)   { const int kb = r / 32, nb = r % 32; I.W = INP(I_WSO) + (size_t)l * WM * DM; I.ldw = DM; I.src_n0 = 64 * nb; I.k0 = 64 * kb; I.WT = (bf16*)(wl + W_M) + WM; I.ldt = Y3W; I.dst_n0 = 64 * nb; return; } r -= IT_SO;
    if (r < IT_GO)   { const int kb = r / 32, nb = r % 32; I.W = INP(I_WGO) + (size_t)l * WM * DM; I.ldw = DM; I.src_n0 = 64 * nb; I.k0 = 64 * kb; I.WT = (bf16*)(wl + W_M) + 2 * WM; I.ldt = Y3W; I.dst_n0 = 64 * nb; return; } r -= IT_GO;
    if (r < IT_O)    { const int kb = r / 32, nb = r % 32; I.W = INP(I_WO) + (size_t)l * DM * DM; I.ldw = DM; I.src_n0 = 64 * nb; I.k0 = 64 * kb; I.WT = (bf16*)(wl + W_O); I.ldt = DM; I.dst_n0 = 64 * nb; return; } r -= IT_O;
    if (r < IT_F1)   { const int kb = r / 176, nb = r % 176; const int nd = 64 * nb;
                       I.W = INP(I_WF1) + (size_t)l * DM * 2 * DFF; I.ldw = 2 * DFF; I.src_n0 = ((nd >> 7) & 1) * DFF + 128 * (nd >> 8) + (nd & 127); I.k0 = 64 * kb; I.WT = (bf16*)(wl + W_F1); I.ldt = DM; I.dst_n0 = nd;
                       I.gain = INP(I_NFFN) + l * DM; return; } r -= IT_F1;
    { const int kb = r / 32, nb = r % 32; I.W = INP(I_WF2) + (size_t)l * DFF * DM; I.ldw = DM; I.src_n0 = 64 * nb; I.k0 = 64 * kb; I.WT = (bf16*)(wl + W_F2); I.ldt = DFF; I.dst_n0 = 64 * nb; }
}
__device__ __forceinline__ void convert_weights_layer(const Frame& F0, int l, int w0, int nw, int it_lo = 0, int it_hi = IT_LAYER) {
    SITE(F0);
    KARGS();
    LAS float* scr = (LAS float*)(F.lds + F.wave * 16640);
    unsigned char* wl = F.ws + WS_W + (size_t)l * W_LAYER;
    int it = it_lo + w0;
    if (it >= it_hi) return;
    CvItem A, B; f32x4 va[16], vb[16], ga[2], gb[2];
    cv_decode(kargs, wl, l, it, A); cv_load(A, va, ga, F.lane);
    for (;;) {
        it += nw; const bool hb = it < it_hi;
        if (hb) { cv_decode(kargs, wl, l, it, B); cv_load(B, vb, gb, F.lane); }
        cv_store(A, va, ga, scr, F.lane);
        if (!hb) break;
        it += nw; const bool ha = it < it_hi;
        if (ha) { cv_decode(kargs, wl, l, it, A); cv_load(A, va, ga, F.lane); }
        cv_store(B, vb, gb, scr, F.lane);
        if (!ha) break;
    }
}
__device__ __forceinline__ void prologue_x(const Frame& F0) {
    SITE(F0);
    KARGS();
    const int gw = F.vcu * NWAVES + F.wave, NGW = F.G * NWAVES;
    float* ssq = WSP(float, WS_SSQ); bf16* XB = WSP(bf16, WS_XB);
    for (int r = gw; r < M; r += NGW) {
        const float* src = r < MP ? INP(I_XP) + (size_t)r * DM : INP(I_XS) + (size_t)(r - MP) * DM;
        f32x4 v[8]; float s = 0.f;
#pragma unroll
        for (int j = 0; j < 8; ++j) { v[j] = ((const f32x4*)src)[F.lane + 64 * j]; s += (v[j].x * v[j].x + v[j].y * v[j].y) + (v[j].z * v[j].z + v[j].w * v[j].w); }
        s = wave_sum(s);
#pragma unroll
        for (int j = 0; j < 8; ++j) { v2u w; w.x = cvt_pk(v[j].x, v[j].y); w.y = cvt_pk(v[j].z, v[j].w); ((v2u*)(XB + (size_t)r * DM))[F.lane + 64 * j] = w; }
        const float rstd = rsqrtf(s * (1.0f / DM) + EPS), sc = X8_SCALE * rstd;
#pragma unroll
        for (int j = 0; j < 8; ++j) ((unsigned*)(F.ws + WS_XB8 + (size_t)r * DM))[F.lane + 64 * j] = pack4_i8(v[j].x, v[j].y, v[j].z, v[j].w, sc);
        if (F.lane < 32) ssq[(size_t)r * 32 + F.lane] = F.lane == 0 ? s : 0.f;
        if (F.lane == 0) { WSP(float, WS_RSTD)[r] = rstd; WSP(float, WS_S8)[r] = sc; }
    }
}
__device__ __forceinline__ void prologue_ssm(const Frame& F0) {
    SITE(F0);
    KARGS();
    for (int idx = (F.vcu * NWAVES + F.wave) * 64 + F.lane; idx < DEPTH * SG * SP; idx += F.G * NTHREADS) {
        const int l = idx / (SG * SP), gp = idx % (SG * SP), g = gp / SP, p = gp % SP;
        const double lre = INP(I_LRE)[idx], lim = INP(I_LIM)[idx], dt = exp((double)INP(I_LDT)[l * SG + g]);
        const double ar = lre * dt, ai = lim * dt, mag = exp(ar), lbr = mag * cos(ai), lbi = mag * sin(ai);
        ((f32x2*)(F.ws + WS_SSMC + (size_t)l * SSMC_LAYER + SSMC_LB))[gp] = (f32x2){(float)lbr, (float)lbi};
        unsigned char* tab = F.ws + WS_TAB + (size_t)l * TAB_LAYER;
        double pr = lbr, pi = lbi;
#pragma unroll
        for (int k = 0; k < 5; ++k) { const double t = pr * pr - pi * pi; pi = 2.0 * pr * pi; pr = t; }
        f32x2* pw = (f32x2*)(tab + T_LPOW) + (size_t)gp * 14;
        double qr = pr, qi = pi;
#pragma unroll
        for (int j = 0; j < 8; ++j) { pw[j] = (f32x2){(float)qr, (float)qi}; if (j < 7) { const double t = qr * pr - qi * pi; qi = qr * pi + qi * pr; qr = t; } }
#pragma unroll
        for (int k = 0; k < 6; ++k) { pw[8 + k] = (f32x2){(float)qr, (float)qi}; const double t = qr * qr - qi * qi; qi = 2.0 * qr * qi; qr = t; }
        const double nr = lbr - 1.0, ni = lbi, den = lre * lre + lim * lim, cr = (nr * lre + ni * lim) / den, ci = (ni * lre - nr * lim) / den;
        bf16* bbt = (bf16*)(tab + T_BBT) + (size_t)g * 4 * 32 * 16;
        bf16* cmt = (bf16*)(tab + T_CMT) + (size_t)g * 16 * 128;
#pragma unroll
        for (int i = 0; i < SI; ++i) {
            const double br = INP(I_BRE)[(size_t)idx * SI + i], bi = INP(I_BIM)[(size_t)idx * SI + i];
            const unsigned w = cvt_pk((float)(cr * br - ci * bi), (float)(cr * bi + ci * br));
            bbt[(((p >> 5)) * 32 + (p & 31)) * 16 + i] = (bf16)(w & 0xffffu);
            bbt[((2 + (p >> 5)) * 32 + (p & 31)) * 16 + i] = (bf16)(w >> 16);
            const size_t ci_ = (((size_t)l * SG + g) * SI + i) * SP + p;
            const unsigned wc = cvt_pk(INP(I_CRE)[ci_], -INP(I_CIM)[ci_]);
            cmt[i * 128 + p] = (bf16)(wc & 0xffffu); cmt[i * 128 + 64 + p] = (bf16)(wc >> 16);
        }
    }
}

__device__ __forceinline__ void phase_conv(const Frame& F0, int l) {
    SITE(F0);
    KARGS();
    const bf16* H = WSP(bf16, WS_H); bf16* ZA = WSP(bf16, WS_Y3);
    const float* cw = INP(I_CONVW) + (size_t)l * 3 * WM; const float* cache = INP(I_CACHE) + (size_t)l * NSB * 2 * WM;
    const size_t NT = (size_t)F.G * NTHREADS;
    for (size_t it = (size_t)F.vcu * NTHREADS + F.tid; it < (size_t)M * 128; it += NT) {
        const int r = (int)(it >> 7), c = (int)(it & 127) * 8;
        const bool samp = r >= MP; const int b = samp ? (r - MP) >> 5 : 0, t = samp ? (r - MP) & 31 : r;
        const bf16* hr = H + (size_t)r * DIN;
        float z0[8], z1[8], z2[8], bg[8];
        unpack8(*(const v4u*)(hr + OFF_CG + c), z0);
        if (t >= 1) unpack8(*(const v4u*)(hr - DIN + OFF_CG + c), z1);
        else {
#pragma unroll
            for (int j = 0; j < 8; ++j) z1[j] = samp ? cache[((size_t)b * 2 + 1) * WM + c + j] : 0.f; }
        if (t >= 2) unpack8(*(const v4u*)(hr - 2 * DIN + OFF_CG + c), z2);
        else {
#pragma unroll
            for (int j = 0; j < 8; ++j) z2[j] = samp ? cache[((size_t)b * 2 + t) * WM + c + j] : 0.f; }
        unpack8(*(const v4u*)(hr + OFF_BG + c), bg);
        float f[8];
#pragma unroll
        for (int j = 0; j < 8; ++j) f[j] = bg[j] * (cw[c + j] * z2[j] + cw[WM + c + j] * z1[j] + cw[2 * WM + c + j] * z0[j]);
        *(v4u*)(ZA + (size_t)r * Y3W + c) = pack8(f);
        const int tl = samp ? LSQ : MP;
        if (t >= tl - 2) {
            float* o = samp ? F.out + O_CONVS + (((size_t)l * NSB + b) * 2 + (t - (tl - 2))) * WM + c : F.out + O_CONVP + ((size_t)l * 2 + (t - (tl - 2))) * WM + c;
            *(f32x4*)o = (f32x4){z0[0], z0[1], z0[2], z0[3]}; *(f32x4*)(o + 4) = (f32x4){z0[4], z0[5], z0[6], z0[7]};
        }
    }
}
__device__ __forceinline__ void phase_ln(const Frame& F0, int l) {
    SITE(F0);
    KARGS();
    const bf16* H = WSP(bf16, WS_H); bf16* VN = WSP(bf16, WS_VN); const float* lg = INP(I_LNV) + (size_t)l * WM;
    const int gw = F.vcu * NWAVES + F.wave, NGW = F.G * NWAVES;
    for (int r = gw; r < M; r += NGW) {
        float v[16];
#pragma unroll
        for (int h = 0; h < 2; ++h) { float t[8]; unpack8(*(const v4u*)(H + (size_t)r * DIN + OFF_VG + 8 * F.lane + 512 * h), t);
#pragma unroll
            for (int j = 0; j < 8; ++j) v[8 * h + j] = gelu_t(t[j]); }
        float s = 0.f;
#pragma unroll
        for (int j = 0; j < 16; ++j) s += v[j];
        const float mean = wave_sum(s) * (1.0f / WM); float q = 0.f;
#pragma unroll
        for (int j = 0; j < 16; ++j) { v[j] -= mean; q += v[j] * v[j]; }
        const float rstd = rsqrtf(wave_sum(q) * (1.0f / WM) + EPS);
#pragma unroll
        for (int h = 0; h < 2; ++h) { const int c = 8 * F.lane + 512 * h; float f[8];
            const f32x4 g0 = *(const f32x4*)(lg + c), g1 = *(const f32x4*)(lg + c + 4);
#pragma unroll
            for (int j = 0; j < 4; ++j) { f[j] = v[8 * h + j] * rstd * g0[j]; f[4 + j] = v[8 * h + 4 + j] * rstd * g1[j]; }
            *(v4u*)(VN + (size_t)r * WM + c) = pack8(f);
            if (r >= MP) { float* o = F.out + O_VS + ((size_t)l * NSB * LSQ + (r - MP)) * WM + c; *(f32x4*)o = (f32x4){f[0], f[1], f[2], f[3]}; *(f32x4*)(o + 4) = (f32x4){f[4], f[5], f[6], f[7]}; }
        }
    }
}
__device__ __forceinline__ void prologue_wsb(const Frame& F0) {
    SITE(F0);
    KARGS();
    for (int idx = (F.vcu * NWAVES + F.wave) * 64 + F.lane; idx < DEPTH * 8 * 128 * 128; idx += F.G * NTHREADS) {
        const int l = idx >> 17, rem = idx & 131071, t = (rem >> 7) & 127, s = rem & 127;
        const float v = s <= t ? INP(I_WS)[idx] : 0.f;
        ((bf16*)(F.ws + WS_TAB + (size_t)l * TAB_LAYER + T_WSB))[rem] = (bf16)(cvt_pk(v, 0.f) & 0xffffu);
    }
}
__device__ __forceinline__ void phase_sgu_m(const Frame& F0, int l) {
    SITE(F0);
    KARGS();
    const bf16* H = WSP(bf16, WS_H); const bf16* VN = WSP(bf16, WS_VN); bf16* YC = WSP(bf16, WS_Y3) + 2 * WM;
    const bf16* WSb = (const bf16*)(F.ws + WS_TAB + (size_t)l * TAB_LAYER + T_WSB);
    const float* bs = INP(I_BS) + (size_t)l * 8 * 128;
    LAS bf16* vt = (LAS bf16*)F.lds;
    const int r = F.lane & 31, hh = F.lane >> 5, w = F.wave;
    const int rp = 16 * ((r >> 2) & 1) + 4 * (r >> 3) + (r & 3);
    for (int bu = F.vcu; bu < 1024 + 64; bu += F.G) {
        __syncthreads();
        if (bu < 1024) {
            const int c = bu >> 3, h = bu & 7, r0 = c * 128;
#pragma unroll
            for (int k = 0; k < 4; ++k) {
                const int q = F.tid + NTHREADS * k, s = q >> 4, dg = q & 15;
                const v4u v = *(const v4u*)(VN + (size_t)(r0 + s) * WM + h * 128 + 8 * dg);
                const int col = (((s >> 3) ^ dg) << 3) + (s & 7);
                LAS bf16* p = vt + (8 * dg) * 136 + col;
                p[0 * 136] = (bf16)(v.x & 0xffffu); p[1 * 136] = (bf16)(v.x >> 16); p[2 * 136] = (bf16)(v.y & 0xffffu); p[3 * 136] = (bf16)(v.y >> 16);
                p[4 * 136] = (bf16)(v.z & 0xffffu); p[5 * 136] = (bf16)(v.z >> 16); p[6 * 136] = (bf16)(v.w & 0xffffu); p[7 * 136] = (bf16)(v.w >> 16);
            }
            LDS_WAIT();
            __syncthreads();
            const int tb = w & 3, db0 = (w >> 2) * 2;
            f32x16 acc[2];
#pragma unroll
            for (int e = 0; e < 2; ++e)
#pragma unroll
                for (int i = 0; i < 16; ++i) acc[e][i] = 0.f;
            const bf16* wrow = WSb + ((size_t)h * 128 + 32 * tb + r) * 128 + 8 * hh;
            for (int ks = 0; ks < 2 * tb + 2; ++ks) {
                const bf16x8 bfr = *(const bf16x8*)(wrow + 16 * ks);
#pragma unroll
                for (int e = 0; e < 2; ++e) { const int d = 32 * (db0 + e) + rp, m = (2 * ks + hh) ^ ((d >> 3) & 15);
                    const bf16x8 afr = *(const LAS bf16x8*)(vt + d * 136 + m * 8);
                    acc[e] = MFMA32(afr, bfr, acc[e]); }
            }
            const int t = 32 * tb + r; const float bias = bs[h * 128 + t]; const size_t row = (size_t)(r0 + t);
#pragma unroll
            for (int e = 0; e < 2; ++e)
#pragma unroll
                for (int hq = 0; hq < 2; ++hq) {
                    const int ch = h * 128 + 32 * (db0 + e) + 16 * hh + 8 * hq;
                    float ug[8], f[8]; unpack8(*(const v4u*)(H + row * DIN + OFF_UG + ch), ug);
#pragma unroll
                    for (int j = 0; j < 8; ++j) f[j] = gelu_t(ug[j]) * (acc[e][8 * hq + j] + bias);
                    *(v4u*)(YC + row * Y3W + ch) = pack8(f);
                }
        } else {
            const int su = bu - 1024, h = su & 7, bq = su >> 3;
#pragma unroll
            for (int k = 0; k < 4; ++k) {
                const int q = F.tid, s = q >> 4, dg = q & 15;
                const v4u v = *(const v4u*)(VN + (size_t)(MP + (4 * bq + k) * 32 + s) * WM + h * 128 + 8 * dg);
                const int col = (((s >> 3) ^ (dg & 3)) << 3) + (s & 7);
                LAS bf16* p = vt + k * (128 * 40) + (8 * dg) * 40 + col;
                p[0 * 40] = (bf16)(v.x & 0xffffu); p[1 * 40] = (bf16)(v.x >> 16); p[2 * 40] = (bf16)(v.y & 0xffffu); p[3 * 40] = (bf16)(v.y >> 16);
                p[4 * 40] = (bf16)(v.z & 0xffffu); p[5 * 40] = (bf16)(v.z >> 16); p[6 * 40] = (bf16)(v.w & 0xffffu); p[7 * 40] = (bf16)(v.w >> 16);
            }
            LDS_WAIT();
            __syncthreads();
            const int bb = w >> 1, db0 = (w & 1) * 2;
            f32x16 acc[2];
#pragma unroll
            for (int e = 0; e < 2; ++e)
#pragma unroll
                for (int i = 0; i < 16; ++i) acc[e][i] = 0.f;
            const bf16* wrow = WSb + ((size_t)h * 128 + r) * 128 + 8 * hh;
#pragma unroll
            for (int ks = 0; ks < 2; ++ks) {
                const bf16x8 bfr = *(const bf16x8*)(wrow + 16 * ks);
#pragma unroll
                for (int e = 0; e < 2; ++e) { const int d = 32 * (db0 + e) + rp, m = (2 * ks + hh) ^ ((d >> 3) & 3);
                    const bf16x8 afr = *(const LAS bf16x8*)(vt + bb * (128 * 40) + d * 40 + m * 8);
                    acc[e] = MFMA32(afr, bfr, acc[e]); }
            }
            const int t = r; const float bias = bs[h * 128 + t]; const size_t row = (size_t)(MP + (4 * bq + bb) * 32 + t);
#pragma unroll
            for (int e = 0; e < 2; ++e)
#pragma unroll
                for (int hq = 0; hq < 2; ++hq) {
                    const int ch = h * 128 + 32 * (db0 + e) + 16 * hh + 8 * hq;
                    float ug[8], f[8]; unpack8(*(const v4u*)(H + row * DIN + OFF_UG + ch), ug);
#pragma unroll
                    for (int j = 0; j < 8; ++j) f[j] = gelu_t(ug[j]) * (acc[e][8 * hq + j] + bias);
                    *(v4u*)(YC + row * Y3W + ch) = pack8(f);
                }
        }
    }
}
#define S5_ROTATE(S, lam0, lam1) do { _Pragma("unroll") for (int i_ = 0; i_ < 16; ++i_) { \
        const float re0 = S[0][i_], im0 = S[2][i_], re1 = S[1][i_], im1 = S[3][i_]; \
        S[0][i_] = lam0.x * re0 - lam0.y * im0; S[2][i_] = lam0.x * im0 + lam0.y * re0; \
        S[1][i_] = lam1.x * re1 - lam1.y * im1; S[3][i_] = lam1.x * im1 + lam1.y * re1; } } while (0)
__device__ __forceinline__ void phase_s1m(const Frame& F0, int l) {
    SITE(F0);
    const bf16* H = WSP(bf16, WS_H); float* E2 = WSP(float, WS_E2);
    const unsigned char* tab = F.ws + WS_TAB + (size_t)l * TAB_LAYER;
    const f32x2* LB = (const f32x2*)(F.ws + WS_SSMC + (size_t)l * SSMC_LAYER + SSMC_LB);
    const int gw = F.vcu * NWAVES + F.wave, NGW = F.G * NWAVES, r = F.lane & 31, hh = F.lane >> 5;
    for (int task = F.wave * F.G + F.vcu; task < 1024; task += NGW) {
        const int g = task & 63, cb = task >> 6;
        bf16x8 bfr[4];
#pragma unroll
        for (int b = 0; b < 4; ++b) bfr[b] = *(const bf16x8*)((const bf16*)(tab + T_BBT) + (((size_t)g * 4 + b) * 32 + r) * 16 + 8 * hh);
        const f32x2 lam0 = LB[g * SP + r], lam1 = LB[g * SP + 32 + r];
        const bf16* up = H + (size_t)((cb * 32 + r) * CH) * DIN + OFF_US + g * SI + 8 * hh;
        f32x16 S[4];
#pragma unroll
        for (int b = 0; b < 4; ++b)
#pragma unroll
            for (int i = 0; i < 16; ++i) S[b][i] = 0.f;
        bf16x8 ub[4];
#pragma unroll
        for (int k = 0; k < 4; ++k) ub[k] = *(const bf16x8*)(up + (size_t)k * DIN);
        const bf16* pf = up + (size_t)4 * DIN;
#pragma unroll 1
        for (int t0 = 0; t0 < CH; t0 += 4) {
#pragma unroll
            for (int k = 0; k < 4; ++k) {
                const bf16x8 a = ub[k];
                if (t0 + 4 < CH) ub[k] = *(const bf16x8*)pf;
                pf += DIN; LAUNDER_G(pf, "+v");
                S5_ROTATE(S, lam0, lam1);
#pragma unroll
                for (int b = 0; b < 4; ++b) S[b] = MFMA32(a, bfr[b], S[b]);
            }
        }
#pragma unroll
        for (int b = 0; b < 4; ++b) {
            float* ep = E2 + ((((size_t)g * 2 + (b >> 1)) * SP + 32 * (b & 1) + r) * NCH) + cb * 32 + 4 * hh;
#pragma unroll
            for (int rq = 0; rq < 4; ++rq) *(f32x4*)(ep + 8 * rq) = (f32x4){S[b][4 * rq], S[b][4 * rq + 1], S[b][4 * rq + 2], S[b][4 * rq + 3]};
        }
    }
}
__device__ __forceinline__ void phase_s2m(const Frame& F0, int l) {
    SITE(F0);
    float* E2 = WSP(float, WS_E2);
    const int gw = F.vcu * NWAVES + F.wave, NGW = F.G * NWAVES;
    for (int task = gw; task < SG * SP; task += NGW) {
        const int g = task >> 6, p = task & 63;
        float* er = E2 + (((size_t)g * 2 + 0) * SP + p) * NCH + 8 * F.lane; float* ei = er + (size_t)SP * NCH;
        const f32x2* pw = (const f32x2*)(F.ws + WS_TAB + (size_t)l * TAB_LAYER + T_LPOW) + (size_t)task * 14;
        float ar[8], ai[8];
        { const f32x4 x0 = *(const f32x4*)er, x1 = *(const f32x4*)(er + 4), y0 = *(const f32x4*)ei, y1 = *(const f32x4*)(ei + 4);
          ar[0] = x0.x; ar[1] = x0.y; ar[2] = x0.z; ar[3] = x0.w; ar[4] = x1.x; ar[5] = x1.y; ar[6] = x1.z; ar[7] = x1.w;
          ai[0] = y0.x; ai[1] = y0.y; ai[2] = y0.z; ai[3] = y0.w; ai[4] = y1.x; ai[5] = y1.y; ai[6] = y1.z; ai[7] = y1.w; }
        const f32x2 q1 = pw[0];
#pragma unroll
        for (int j = 1; j < 8; ++j) { const float nr = q1.x * ar[j - 1] - q1.y * ai[j - 1] + ar[j], ni = q1.x * ai[j - 1] + q1.y * ar[j - 1] + ai[j]; ar[j] = nr; ai[j] = ni; }
        float xr = ar[7], xi = ai[7];
#pragma unroll
        for (int k = 0; k < 6; ++k) { const f32x2 rk = pw[8 + k]; const float yr = __shfl_up(xr, 1 << k), yi = __shfl_up(xi, 1 << k);
            if (F.lane >= (1 << k)) { xr += rk.x * yr - rk.y * yi; xi += rk.x * yi + rk.y * yr; } }
        float cr = __shfl_up(xr, 1), ci = __shfl_up(xi, 1);
        if (F.lane == 0) { cr = 0.f; ci = 0.f; }
        if (F.lane == 63) { F.out[O_SREP + ((size_t)l * SG + g) * SP + p] = xr; F.out[O_SIMP + ((size_t)l * SG + g) * SP + p] = xi; }
        float sr[8], si[8]; sr[0] = cr; si[0] = ci;
#pragma unroll
        for (int j = 1; j < 8; ++j) { const f32x2 qj = pw[j - 1]; sr[j] = ar[j - 1] + qj.x * cr - qj.y * ci; si[j] = ai[j - 1] + qj.x * ci + qj.y * cr; }
        *(f32x4*)er = (f32x4){sr[0], sr[1], sr[2], sr[3]}; *(f32x4*)(er + 4) = (f32x4){sr[4], sr[5], sr[6], sr[7]};
        *(f32x4*)ei = (f32x4){si[0], si[1], si[2], si[3]}; *(f32x4*)(ei + 4) = (f32x4){si[4], si[5], si[6], si[7]};
    }
}
__device__ __forceinline__ void phase_s3m(const Frame& F0, int l) {
    SITE(F0);
    KARGS();
    const bf16* H = WSP(bf16, WS_H); const float* E2 = WSP(float, WS_E2); bf16* YS = WSP(bf16, WS_YS);
    const unsigned char* tab = F.ws + WS_TAB + (size_t)l * TAB_LAYER;
    const f32x2* LB = (const f32x2*)(F.ws + WS_SSMC + (size_t)l * SSMC_LAYER + SSMC_LB);
    constexpr int SLP = 168;
    LAS bf16* sl = (LAS bf16*)(F.lds + F.wave * 16128);
    LAS bf16* cml = sl + 32 * SLP;
    { unsigned z = 0u; asm volatile("" : "+v"(z)); const v4u zz = {z, z, z, z};
      if (F.lane < 32) *(LAS v4u*)(sl + F.lane * SLP + 144) = zz, *(LAS v4u*)(sl + F.lane * SLP + 152) = zz; }
    const int gw = F.vcu * NWAVES + F.wave, NGW = F.G * NWAVES, r = F.lane & 31, hh = F.lane >> 5, c16 = F.lane & 15, q4 = F.lane >> 4;
    for (int task = F.wave * F.G + F.vcu; task < 1024 + 64; task += NGW) {
        const bool samp = task >= 1024; const int q = samp ? task - 1024 : task, g = q & 63, cb = q >> 6;
        bf16x8 bfr[4];
#pragma unroll
        for (int b = 0; b < 4; ++b) bfr[b] = *(const bf16x8*)((const bf16*)(tab + T_BBT) + (((size_t)g * 4 + b) * 32 + r) * 16 + 8 * hh);
#pragma unroll
        for (int k = 0; k < 4; ++k) { const int pc = F.lane + 64 * k, ii = pc >> 4, cc = (pc & 15) * 8;
            *(LAS bf16x8*)(cml + ii * SLP + cc) = *(const bf16x8*)((const bf16*)(tab + T_CMT) + ((size_t)g * 16 + ii) * 128 + cc); }
        { const int ii = F.lane >> 2, part = F.lane & 3; const unsigned dv = cvt_pk(INP(I_SD)[(size_t)l * WM + g * SI + ii], 0.f) & 0xffffu;
          v4u w = (v4u){0u, 0u, 0u, 0u}; const int e = ii - 8 * part;
          if (e >= 0 && e < 8) { const unsigned x = dv << (16 * (e & 1)); if ((e >> 1) == 0) w.x = x; else if ((e >> 1) == 1) w.y = x; else if ((e >> 1) == 2) w.z = x; else w.w = x; }
          *(LAS v4u*)(cml + ii * SLP + 128 + 8 * part) = w; }
        const f32x2 lam0 = LB[g * SP + r], lam1 = LB[g * SP + 32 + r];
        const size_t rowA = samp ? (size_t)(MP + r * LSQ) : (size_t)((cb * 32 + r) * CH);
        const bf16* up = H + rowA * DIN + OFF_US + g * SI + 8 * hh;
        f32x16 S[4];
        if (samp) {
            int hh1 = hh; asm volatile("" : "+v"(hh1));
#pragma unroll
            for (int b = 0; b < 4; ++b) { const float* st = (b < 2 ? INP(I_STRE) : INP(I_STIM)) + (size_t)l * NSB * SG * SP + (size_t)g * SP + 32 * (b & 1) + r + (size_t)(4 * hh1) * SG * SP;
#pragma unroll
                for (int i = 0; i < 16; ++i) S[b][i] = st[(size_t)((i & 3) + 8 * (i >> 2)) * SG * SP]; }
        } else {
#pragma unroll
            for (int b = 0; b < 4; ++b) { const float* ep = E2 + ((((size_t)g * 2 + (b >> 1)) * SP + 32 * (b & 1) + r) * NCH) + cb * 32 + 4 * hh;
#pragma unroll
                for (int rq = 0; rq < 4; ++rq) { const f32x4 x = *(const f32x4*)(ep + 8 * rq); S[b][4 * rq] = x.x; S[b][4 * rq + 1] = x.y; S[b][4 * rq + 2] = x.z; S[b][4 * rq + 3] = x.w; } }
        }
        const int ch = g * SI + 4 * q4;
        bf16* yo[2];
#pragma unroll
        for (int cblk = 0; cblk < 2; ++cblk) { const size_t row = samp ? (size_t)(MP + (16 * cblk + c16) * LSQ) : (size_t)((cb * 32 + 16 * cblk + c16) * CH);
            yo[cblk] = YS + row * WM + ch; }
        bf16x8 ub[4];
#pragma unroll
        for (int k = 0; k < 4; ++k) ub[k] = *(const bf16x8*)(up + (size_t)k * DIN);
        const bf16* pf = up + (size_t)4 * DIN;
#pragma unroll 1
        for (int t0 = 0; t0 < CH; t0 += 4) {
#pragma unroll
            for (int k = 0; k < 4; ++k) {
                const bf16x8 a = ub[k];
                if (t0 + 4 < CH) ub[k] = *(const bf16x8*)pf;
                pf += DIN; LAUNDER_G(pf, "+v");
                S5_ROTATE(S, lam0, lam1);
#pragma unroll
                for (int b = 0; b < 4; ++b) S[b] = MFMA32(a, bfr[b], S[b]);
#pragma unroll
                for (int b = 0; b < 4; ++b)
#pragma unroll
                    for (int i = 0; i < 16; i += 2) { const unsigned w = cvt_pk(S[b][i], S[b][i + 1]); LAS bf16* p = sl + ((i & 3) + 8 * (i >> 2) + 4 * hh) * SLP + 32 * b + r;
                        p[0] = (bf16)(w & 0xffffu); p[SLP] = (bf16)(w >> 16); }
                *(LAS bf16x8*)(sl + r * SLP + 128 + 8 * hh) = a;
                LDS_WAIT();
#pragma unroll
                for (int cblk = 0; cblk < 2; ++cblk) {
                    f32x4 y = (f32x4){0.f, 0.f, 0.f, 0.f};
#pragma unroll
                    for (int ks = 0; ks < 5; ++ks) { const bf16x8 sb = *(const LAS bf16x8*)(sl + (16 * cblk + c16) * SLP + 32 * ks + 8 * q4); const bf16x8 ca = *(const LAS bf16x8*)(cml + c16 * SLP + 32 * ks + 8 * q4); y = MFMA16(ca, sb, y); }
                    v2u o; o.x = cvt_pk(gelu_t(y[0]), gelu_t(y[1])); o.y = cvt_pk(gelu_t(y[2]), gelu_t(y[3]));
                    *(v2u*)yo[cblk] = o;
                    yo[cblk] += WM; LAUNDER_G(yo[cblk], "+v");
                }
                LDS_WAIT();
                __builtin_amdgcn_sched_barrier(0);
            }
        }
        if (samp) {
            int hh2 = hh; asm volatile("" : "+v"(hh2));
#pragma unroll
            for (int b = 0; b < 4; ++b) { float* so = F.out + (b < 2 ? O_SRES : O_SIMS) + (size_t)l * NSB * SG * SP + (size_t)g * SP + 32 * (b & 1) + r + (size_t)(4 * hh2) * SG * SP;
#pragma unroll
                for (int i = 0; i < 16; ++i) so[(size_t)((i & 3) + 8 * (i >> 2)) * SG * SP] = S[b][i]; }
        }
    }
}
__device__ __forceinline__ void phase_final(const Frame& F0) {
    SITE(F0);
    KARGS();
    const int gw = F.vcu * NWAVES + F.wave, NGW = F.G * NWAVES; const float* gn = INP(I_NFIN); const bf16* XB = WSP(bf16, WS_XB);
    for (int r = gw; r < M; r += NGW) {
        float* yr = F.out + O_Y + (size_t)r * DM; float v[4][8]; float s = 0.f;
#pragma unroll
        for (int j = 0; j < 4; ++j) { unpack8(*(const v4u*)(XB + (size_t)r * DM + 8 * F.lane + 512 * j), v[j]);
#pragma unroll
            for (int e = 0; e < 8; ++e) s += v[j][e] * v[j][e]; }
        const float rstd = rsqrtf(wave_sum(s) * (1.0f / DM) + EPS);
#pragma unroll
        for (int j = 0; j < 4; ++j) { const int c = 8 * F.lane + 512 * j; const f32x4 g0 = *(const f32x4*)(gn + c), g1 = *(const f32x4*)(gn + c + 4);
            *(f32x4*)(yr + c) = (f32x4){v[j][0] * rstd * g0.x, v[j][1] * rstd * g0.y, v[j][2] * rstd * g0.z, v[j][3] * rstd * g0.w};
            *(f32x4*)(yr + c + 4) = (f32x4){v[j][4] * rstd * g1.x, v[j][5] * rstd * g1.y, v[j][6] * rstd * g1.z, v[j][7] * rstd * g1.w}; }
    }
}

constexpr int PH_PER_LAYER = 9, N_PHASES = 2 + DEPTH * PH_PER_LAYER;

__global__ void __launch_bounds__(NTHREADS, 2) fwd(Args args) {
    extern __shared__ __attribute__((aligned(16))) unsigned char lds_raw[];
    Frame F;
    F.lds = (LAS unsigned char*)lds_raw;
    F.tid = threadIdx.x; F.lane = F.tid & 63; F.wave = __builtin_amdgcn_readfirstlane(F.tid >> 6);
    F.G = gridDim.x; { const int bx = blockIdx.x; F.vcu = (F.G % 8 == 0) ? (bx % 8) * (F.G / 8) + bx / 8 : bx; }
    F.out = args.out; F.ws = args.ws;
    volatile LAS unsigned* misc = (volatile LAS unsigned*)(F.lds + MISC_OFF);
    if (F.tid < 16) misc[F.tid] = 0u;
    __syncthreads();
    const int lo = args.ph_lo, hi = args.ph_hi;
    unsigned* barw = (unsigned*)(F.ws + WS_CTL) + 4096;
    XcdBarrier bar; bar.bar = barw; bar.x = 0; bar.st = misc; bar.wave = (unsigned)F.wave;
    if (hi - lo > 1) bar = xcd_barrier_post(barw, misc, (unsigned)F.wave);
#define IN(k) (lo <= (k) && (k) < hi)
#define SEAM(k) do { if (IN(k) && IN((k) + 1)) { xcd_barrier(bar); if (DUPMASK & 2048) xcd_barrier(bar); } } while (0)
    const int blk = (int)blockIdx.x;
    const bool bgconv = (F.G == 256) && (hi - lo > 1);
    const bool split = (F.G == 256) && (hi - lo > 1);

    if ((PHMASK & 1) && IN(0)) DUP(1) {
        if (rep_) xcd_barrier(bar);
        const int gw = F.vcu * NWAVES + F.wave, NGW = F.G * NWAVES;
        for (int l = 0; l < DEPTH; ++l) if (l == 0 || !bgconv) convert_weights_layer(F, l, gw, NGW, 0, IT_LAYER);
        prologue_x(F); prologue_ssm(F); prologue_wsb(F);
    }
    SEAM(0);
    for (int l = 0; l < DEPTH; ++l) {
        const int pb = 1 + l * PH_PER_LAYER;
        const Frame& FK = F;
        if ((PHMASK & 2) && IN(pb + 0)) DUP(2) {
            SITE(FK); unsigned char* wl = F.ws + WS_W + (size_t)l * W_LAYER;
            if (rep_) xcd_barrier(bar);
            KARGS();
            pg8::Gemm g{WSP(bf16, WS_XB), (const bf16*)(wl + W_1), M, NB16 * 256, DM, DM, DM, F.ws}; pg8::StaticOrder S; S.init(MP, NB16 * 256, F.G, blk, DM, M - MP, 0, 24, 0);
            EpiH E{WSP(bf16, WS_H), WSP(float, WS_SSQ), split ? WSP(float, WS_RSTD) : nullptr};
            pg8::gemm_phase<EpiH, pg8::StaticOrder, true, true>(F.lds, g, S, E, F.tid);
            pg8::Gemm g8{WSP(bf16, WS_XB8), (const bf16*)(wl + W_1G), M, (48 - NB16) * 256, DM / 2, DM / 2, DM / 2, F.ws}; pg8::StaticOrder S8o; S8o.init(MP, (48 - NB16) * 256, F.G, F.G == 256 ? (blk + 160) & 255 : blk, DM / 2, M - MP, 0, 24, NH8);
            EpiG8 E8{WSP(bf16, WS_H), WSP(bf16, WS_G), WSP(float, WS_SSQ), INP(I_BGATE) + (size_t)l * DIN, split ? WSP(float, WS_RSTD) : nullptr, WSP(float, WS_S8)};
            pg8::gemm_phase<EpiG8, pg8::StaticOrder, true, true, true>(F.lds, g8, S8o, E8, F.tid);
            if (l + 1 < DEPTH && bgconv && blk >= 192) convert_weights_layer(F, l + 1, (blk - 192) * NWAVES + F.wave, 64 * NWAVES, BG_B, BG_C);
        }
        SEAM(pb + 0);
        if ((PHMASK & 4) && IN(pb + 1)) DUP(4) { if (rep_) xcd_barrier(bar); DUP(4096) phase_conv(F, l); DUP(8192) phase_ln(F, l); DUP(16384) phase_s1m(F, l);
            if (l + 1 < DEPTH && bgconv && F.wave >= 4) convert_weights_layer(F, l + 1, F.vcu * 4 + (F.wave - 4), F.G * 4, 0, BG_A); }
        SEAM(pb + 1);
        if ((PHMASK & 8) && IN(pb + 2)) { DUP(32768) phase_s2m(F, l); DUP(8) { if (rep_) xcd_barrier(bar); phase_sgu_m(F, l); } }
        SEAM(pb + 2);
        if ((PHMASK & 16) && IN(pb + 3)) DUP(16) { if (rep_) xcd_barrier(bar); phase_s3m(F, l);
            if (l + 1 < DEPTH && bgconv && F.wave >= 5) convert_weights_layer(F, l + 1, F.vcu * 3 + (F.wave - 5), F.G * 3, BG_A, BG_B); }
        SEAM(pb + 3);
        if ((PHMASK & 32) && IN(pb + 4)) DUP(32) {
            SITE(FK); unsigned char* wl = F.ws + WS_W + (size_t)l * W_LAYER;
            if (rep_) xcd_barrier(bar);
            KARGS();
            pg8::Gemm g{WSP(bf16, WS_YS), (const bf16*)(wl + W_GLU), M, WM, WM, WM, WM, F.ws}; pg8::StaticOrder S; S.init(MP, WM, F.G, blk, WM, split ? 0 : M - MP);
            EpiGLU E{WSP(bf16, WS_YS), WSP(bf16, WS_Y3) + WM, INP(I_BGLU) + (size_t)l * WM, WSP(bf16, WS_H)};
            int l_pm = 0, l_pn = 0, l_kb = 0, l_k0 = 0; bool have2 = false;
            if (split) { int bq = blk; asm volatile("" : "+s"(bq)); pg8::SliceOrder St; St.init(bq, MP / 256, WM, 4, 1, 4); pg8::Unit ut; have2 = St.next(0, ut); if (have2) { l_pm = ut.pm; l_pn = ut.pn; l_kb = ut.kb; l_k0 = ut.k0; } }
            pg8::gemm_phase<EpiGLU, pg8::StaticOrder, true, true>(F.lds, g, S, E, F.tid, have2, l_pm, l_pn, l_kb, l_k0);
            if (split) {
                if (have2) { pg8::SliceOrder S2; S2.init(blk, MP / 256, WM, 4, 1, 4); EpiSlab E2{WSP(bf16, WS_H), 4, 4}; pg8::gemm_phase<EpiSlab, pg8::SliceOrder, true, true, false, true>(F.lds, g, S2, E2, F.tid); }
                xcd_barrier(bar); if (blk < 128) E.reduce(blk >> 3, blk & 7, F.tid);
            }
        }
        SEAM(pb + 4);
        if ((PHMASK & 64) && IN(pb + 5)) DUP(64) {
            SITE(FK); unsigned char* wl = F.ws + WS_W + (size_t)l * W_LAYER;
            if (rep_) xcd_barrier(bar);
            pg8::Gemm g{WSP(bf16, WS_Y3), (const bf16*)(wl + W_M), M, DM, WM, Y3W, Y3W, F.ws}; pg8::ChainOrder S; S.init(MP, DM, F.G, blk, WM, split ? 0 : M - MP);
            EpiMrgC E{WSP(bf16, WS_G), WSP(bf16, WS_MG), WSP(bf16, WS_H)};
            int l_pm = 0, l_pn = 0, l_kb = 0, l_k0 = 0; bool have2 = false;
            if (split) { int bq = blk; asm volatile("" : "+s"(bq)); pg8::SliceOrder St; St.init(bq, MP / 256, WM, 2, 3); pg8::Unit ut; have2 = St.next(0, ut); if (have2) { l_pm = ut.pm; l_pn = ut.pn; l_kb = ut.kb; l_k0 = ut.k0; } }
            pg8::gemm_phase<EpiMrgC, pg8::ChainOrder, true, true>(F.lds, g, S, E, F.tid, have2, l_pm, l_pn, l_kb, l_k0);
            if (split) {
                if (have2) { pg8::SliceOrder S2; S2.init(blk, MP / 256, WM, 2, 3); EpiSlab E2{WSP(bf16, WS_H), 6, 8}; pg8::gemm_phase<EpiSlab, pg8::SliceOrder, true, true, false, true>(F.lds, g, S2, E2, F.tid); }
                xcd_barrier(bar); E.reduce(blk >> 3, blk & 7, F.tid);
            }
        }
        SEAM(pb + 5);
        if ((PHMASK & 128) && IN(pb + 6)) {
            SITE(FK); unsigned char* wl = F.ws + WS_W + (size_t)l * W_LAYER;
            pg8::Gemm g{WSP(bf16, WS_MG), (const bf16*)(wl + W_O), M, DM, DM, DM, DM, F.ws}; pg8::StaticOrder S; S.init(MP, DM, F.G, blk, DM, split ? 0 : M - MP);
            KARGS();
            EpiRes<0> E{F.out + O_Y, WSP(bf16, WS_XB), WSP(float, WS_SSQ), WSP(bf16, WS_H), 0, INP(I_XP), INP(I_XS) - (size_t)MP * DM, l == 0, nullptr, nullptr};
            DUP(128) {
            E.dry = (DUPMASK & 128) && rep_ == 0; if (rep_) xcd_barrier(bar);
            int l_pm = 0, l_pn = 0, l_kb = 0, l_k0 = 0; bool have2 = false;
            if (split) { int bq = blk; asm volatile("" : "+s"(bq)); pg8::SliceOrder St; St.init(bq, MP / 256, DM, 8, 1); pg8::Unit ut; have2 = St.next(0, ut); if (have2) { l_pm = ut.pm; l_pn = ut.pn; l_kb = ut.kb; l_k0 = ut.k0; } }
            pg8::gemm_phase<EpiRes<0>, pg8::StaticOrder, true, true>(F.lds, g, S, E, F.tid, have2, l_pm, l_pn, l_kb, l_k0);
            if (split) {
                if (have2) { pg8::SliceOrder S2; S2.init(blk, MP / 256, DM, 8, 1); EpiSlab E2{WSP(bf16, WS_H), 8, 8}; pg8::gemm_phase<EpiSlab, pg8::SliceOrder, true, true, false, true>(F.lds, g, S2, E2, F.tid); }
                xcd_barrier(bar); E.reduce(blk >> 3, blk & 7, F.tid); rstd_rows(WSP(float, WS_SSQ), WSP(float, WS_RSTD), blk, F.tid);
            }
            }
        }
        SEAM(pb + 6);
        if ((PHMASK & 256) && IN(pb + 7)) DUP(256) {
            SITE(FK); unsigned char* wl = F.ws + WS_W + (size_t)l * W_LAYER;
            if (rep_) xcd_barrier(bar);
            pg8::Gemm g{WSP(bf16, WS_XB), (const bf16*)(wl + W_F1), M, 2 * DFF, DM, DM, DM, F.ws}; pg8::StaticOrder S; S.init(MP, 2 * DFF, F.G, blk, DM, M - MP);
            EpiFFN1 E{WSP(bf16, WS_G), WSP(float, WS_SSQ), split ? WSP(float, WS_RSTD) : nullptr, WSP(float, WS_S8)};
            pg8::gemm_phase<EpiFFN1, pg8::StaticOrder, true, true>(F.lds, g, S, E, F.tid);
            if (l + 1 < DEPTH && bgconv && blk >= 176) convert_weights_layer(F, l + 1, (blk - 176) * NWAVES + F.wave, 80 * NWAVES, BG_C, IT_LAYER);
        }
        SEAM(pb + 7);
        if ((PHMASK & 512) && IN(pb + 8)) {
            SITE(FK); unsigned char* wl = F.ws + WS_W + (size_t)l * W_LAYER;
            pg8::Gemm g{WSP(bf16, WS_G), (const bf16*)(wl + W_F2), M, DM, DFF, DFF, DFF, F.ws}; pg8::StaticOrder S; S.init(MP, DM, F.G, blk, DFF, split ? 0 : M - MP);
            EpiRes<1> E{F.out + O_Y, WSP(bf16, WS_XB), WSP(float, WS_SSQ), WSP(bf16, WS_H), 0, nullptr, nullptr, 0, F.ws + WS_XB8, WSP(float, WS_S8)};
            DUP(512) {
            E.dry = (DUPMASK & 512) && rep_ == 0; if (rep_) xcd_barrier(bar);
            int l_pm = 0, l_pn = 0, l_kb = 0, l_k0 = 0; bool have2 = false;
            if (split) { int bq = blk; asm volatile("" : "+s"(bq)); pg8::SliceOrder St; St.init(bq, MP / 256, DFF, 8, 1); pg8::Unit ut; have2 = St.next(0, ut); if (have2) { l_pm = ut.pm; l_pn = ut.pn; l_kb = ut.kb; l_k0 = ut.k0; } }
            pg8::gemm_phase<EpiRes<1>, pg8::StaticOrder, true, true>(F.lds, g, S, E, F.tid, have2, l_pm, l_pn, l_kb, l_k0);
            if (split) {
                if (have2) { pg8::SliceOrder S2; S2.init(blk, MP / 256, DFF, 8, 1); EpiSlab E2{WSP(bf16, WS_H), 8, 8}; pg8::gemm_phase<EpiSlab, pg8::SliceOrder, true, true, false, true>(F.lds, g, S2, E2, F.tid); }
                xcd_barrier(bar); E.reduce(blk >> 3, blk & 7, F.tid); rstd_rows(WSP(float, WS_SSQ), WSP(float, WS_RSTD), blk, F.tid);
            }
            }
        }
        SEAM(pb + 8);
    }
    if ((PHMASK & 1024) && IN(N_PHASES - 1)) phase_final(F);
#undef IN
#undef SEAM
}

#ifndef PHMASK
#define PHMASK 2047
#endif
#ifndef MK_N_LAUNCHES
#define MK_N_LAUNCHES 1
#endif
extern "C" void kernel_launch(void* const* d_in, const int* in_sizes, int n_in, void* d_out, int out_size, void* d_ws, size_t ws_size, hipStream_t stream) {
    static int grid = 0;
    if (grid == 0) {
        if (n_in != N_IN || (size_t)out_size != O_END || ws_size < WS_END) { fprintf(stderr, "kernel_launch: unexpected shapes: n_in %d out %d ws %zu (need %zu)\n", n_in, out_size, ws_size, (size_t)WS_END); grid = -1; return; }
        int dev = 0, cus = 0, per_cu = 0;
        if (hipGetDevice(&dev) != hipSuccess || hipDeviceGetAttribute(&cus, hipDeviceAttributeMultiprocessorCount, dev) != hipSuccess) { grid = -1; return; }
        if (hipFuncSetAttribute((const void*)fwd, hipFuncAttributeMaxDynamicSharedMemorySize, LDS_BYTES) != hipSuccess) { fprintf(stderr, "kernel_launch: hipFuncSetAttribute failed\n"); grid = -1; return; }
        if (hipOccupancyMaxActiveBlocksPerMultiprocessor(&per_cu, (const void*)fwd, NTHREADS, LDS_BYTES) != hipSuccess || per_cu < 1) fprintf(stderr, "kernel_launch: occupancy query says %d\n", per_cu);
        (void)hipGetLastError();
        grid = cus;
    }
    if (grid < 0) return;
    (void)hipMemsetAsync((char*)d_ws + WS_CTL, 0, CTL_ZERO_BYTES, stream);
    Args a{};
    for (int i = 0; i < N_IN; ++i) a.in[i] = (const float*)d_in[i];
    a.out = (float*)d_out; a.ws = (unsigned char*)d_ws;
    if (MK_N_LAUNCHES == 1) { a.ph_lo = 0; a.ph_hi = N_PHASES; hipLaunchKernelGGL(fwd, dim3(grid), dim3(NTHREADS), LDS_BYTES, stream, a); }
    else for (int p = 0; p < N_PHASES; ++p) { a.ph_lo = p; a.ph_hi = p + 1; hipLaunchKernelGGL(fwd, dim3(grid), dim3(NTHREADS), LDS_BYTES, stream, a); }
}
```

```cpp
#include <hip/hip_runtime.h>
#include <cstdio>
#include <cstdint>
#ifndef PHMASK
#define PHMASK 2047
#endif
#ifndef DUPMASK
#define DUPMASK 0
#endif
#define DUP(bit) for (int rep_ = 0; rep_ < ((DUPMASK & (bit)) ? ((bit) >= 4096 ? 5 : 2) : 1); ++rep_)
namespace pg8 {
#define PG8_LAS __attribute__((address_space(3)))
typedef unsigned short bf16_t;
typedef short bf16x8 __attribute__((ext_vector_type(8)));
typedef float f32x4 __attribute__((ext_vector_type(4)));
typedef unsigned u32x4 __attribute__((ext_vector_type(4)));
typedef int i32x4 __attribute__((ext_vector_type(4)));
constexpr int BM = 256, BK = 64, HALF = 128, HTB = HALF * BK * 2  , STAGE_BYTES = 8 * HTB, NXCD = 8, WGM = 8;

__host__ __device__ __forceinline__ int lds_byte(int r, int c) { const int st = (r >> 4) * 2 + (c >> 5), rr = r & 15, cc = c & 31, ob = rr * 64 + cc * 2; return st * 1024 + (ob ^ (((ob >> 9) & 1) << 5)); }
__host__ __device__ __forceinline__ void stage_rc(int b, int& R, int& C) { const int st = b / 1024, sb = b % 1024, swz = sb ^ (((sb >> 9) & 1) << 5); R = (st >> 1) * 16 + swz / 64; C = (st & 1) * 32 + (swz % 64) / 2; }
__host__ __device__ __forceinline__ int perm32(int rho) { const int n = rho >> 4, i = rho & 15; return 8 * (i >> 2) + 4 * n + (i & 3); }

struct Unit { int pm, pn, kb, k0, nkt, part; };
struct Gemm { const bf16_t* A; const bf16_t* Bt; int M, N, K, lda, ldb; const unsigned char* ws; };
struct StaticOrder {
    int nM, nN, nwg, G, c, nkt, nE, late, nNE, e0;
    __host__ __device__ void init(int M, int N, int G_, int c_, int K, int ME = 0, int late_ = 0, int nNE_ = -1, int e0_ = 0) { nM = M / BM; nN = N / BM; nwg = nM * nN; G = G_; c = c_; nkt = K / BK; nE = ME / BM; late = late_; nNE = nNE_ < 0 ? nN : nNE_; e0 = e0_; }
    __host__ __device__ int place(int pos, int x) const {
        if (late > 0) { const int h = pos >= nN - late, w = h ? late : nN - late, i0 = h ? pos - (nN - late) : pos, i = x < 0 ? i0 : (i0 + (x * w) / NXCD) % w; return h ? i : late + i; }
        return x < 0 ? pos : (pos + (x * nN) / NXCD) % nN; }
    __host__ __device__ bool next(int i, Unit& u) const {
        const long L = (long)i * G + c; u.kb = 0; u.k0 = 0; u.nkt = nkt; u.part = -1;
        if (L >= nwg) { const long e = L - nwg; if (e >= (long)nE * nNE) return false; u.pm = nM + (int)(e % nE); u.pn = e0 + place((int)(e / nE), -1); return true; }
        int wgid = (int)L; { const int q = nwg / NXCD, r = nwg % NXCD, xcd = wgid % NXCD, off = wgid / NXCD; wgid = (xcd < r ? xcd * (q + 1) : r * (q + 1) + (xcd - r) * q) + off; }
        const int nig = WGM * nN, gid = wgid / nig, fm = gid * WGM, gsz = (nM - fm) < WGM ? (nM - fm) : WGM;
        u.pm = fm + ((wgid % nig) % gsz); u.pn = (wgid % nig) / gsz;
        u.pn = place(u.pn, (nM % 64 == 0 && G % NXCD == 0) ? c % NXCD : -1);
        return true;
    }
    __device__ __forceinline__ void a_ready(const Unit&) const {}
    __device__ __forceinline__ void done(const Unit&) const {}
};
struct ChainOrder : StaticOrder {
    __host__ __device__ bool next(int i, Unit& u) const { const int t = i / 3; if (!StaticOrder::next(t, u)) return false; u.kb = i - 3 * t; return true; }
};
struct SliceOrder {
    int c, pm0, nkt, S, seg, npn;
    __host__ __device__ void init(int c_, int pm0_, int K, int S_, int seg_, int npn_ = 8) { c = c_; pm0 = pm0_; nkt = K / BK; S = S_; seg = seg_; npn = npn_; }
    __host__ __device__ bool next(int i, Unit& u) const {
        const int per = S * seg;
        if (i != 0 || c >= 4 * npn * per) return false;
        const int ts = c / per, r = c - per * ts, kb = r / S, sl = r - kb * S;
        u.pm = pm0 + ts / npn; u.pn = ts % npn; u.kb = kb; u.part = r;
        u.k0 = 2 * ((sl * nkt + S) / (2 * S)); u.nkt = 2 * (((sl + 1) * nkt + S) / (2 * S)) - u.k0; return true;
    }
    __device__ __forceinline__ void a_ready(const Unit&) const {}
    __device__ __forceinline__ void done(const Unit&) const {}
};
template <class Epi, class Sched, bool ALIGN_EPI = false, bool SP2 = false, bool F8 = false>
__device__ __forceinline__ void gemm_phase(PG8_LAS unsigned char* lds, const Gemm g, const Sched& S, const Epi& E, int tid_) {
    asm volatile("" : "+v"(tid_));
    const int tid = tid_, wid = __builtin_amdgcn_readfirstlane(tid >> 6), lane = tid & 63, wr = wid >> 2, wc = wid & 3, fr = lane & 15, fq = lane >> 4;
    unsigned voffA[2], voffB[2];
#pragma unroll
    for (int i = 0; i < 2; ++i) { int R, C; stage_rc(tid * 16 + i * 8192, R, C); const int Rb = Epi::PERM ? ((R & ~31) + perm32(R & 31)) : R;
        voffA[i] = (unsigned)(R * g.lda + C) * 2u; voffB[i] = (unsigned)(Rb * g.ldb + C) * 2u; }
    const __amdgpu_buffer_rsrc_t rsrc = __builtin_amdgcn_make_buffer_rsrc((void*)g.ws, (short)0, 0x7fffffff, 0x00020000);
    const unsigned baseA = (unsigned)((const unsigned char*)g.A - g.ws), baseB = (unsigned)((const unsigned char*)g.Bt - g.ws);
    const unsigned kstep = (unsigned)(BK * 2);
    const unsigned kbstep = (unsigned)g.K * 2u;
    const unsigned hstepA = (unsigned)HALF * g.lda * 2u, hstepB = (unsigned)HALF * g.ldb * 2u;
    const unsigned tstepA = 2u * hstepA, tstepB = 2u * hstepB;
    const unsigned ldsw = (unsigned)wid * 1024u;
    const int aoff = lds_byte(wr * 64 + fr, fq * 8), boff = lds_byte(wc * 32 + fr, fq * 8);
#define PG8_SA(b, h) (((b) * 2 + (h)) * HTB)
#define PG8_SB(b, h) ((4 + (b) * 2 + (h)) * HTB)
#define PG8_STAGE(bufoff, goff, voff) do { _Pragma("unroll") for (int _i = 0; _i < 2; ++_i) \
        __builtin_amdgcn_raw_ptr_buffer_load_lds(rsrc, (PG8_LAS void*)(lds + (bufoff) + ldsw + _i * 8192), 16, (voff)[_i], (goff), 0, 0); } while (0)
#define PG8_LDA(dst, b, h) do { _Pragma("unroll") for (int m = 0; m < 4; ++m) _Pragma("unroll") for (int k = 0; k < 2; ++k) dst[m][k] = *(const PG8_LAS bf16x8*)(lds + PG8_SA(b, h) + aoff + m * 2048 + k * 1024); } while (0)
#define PG8_LDB(dst, b, h) do { _Pragma("unroll") for (int n = 0; n < 2; ++n) _Pragma("unroll") for (int k = 0; k < 2; ++k) dst[n][k] = *(const PG8_LAS bf16x8*)(lds + PG8_SB(b, h) + boff + n * 2048 + k * 1024); } while (0)
#define PG8_MMA(ai, bj, At, Bt) do { __builtin_amdgcn_s_setprio(1); _Pragma("unroll") for (int m = 0; m < 4; ++m) _Pragma("unroll") for (int n = 0; n < 2; ++n) _Pragma("unroll") for (int k = 0; k < 2; ++k) { \
        if constexpr (F8) acc[ai][bj][m][n] = __builtin_bit_cast(f32x4, __builtin_amdgcn_mfma_i32_16x16x64_i8(__builtin_bit_cast(i32x4, Bt[n][k]), __builtin_bit_cast(i32x4, At[m][k]), __builtin_bit_cast(i32x4, acc[ai][bj][m][n]), 0, 0, 0)); \
        else acc[ai][bj][m][n] = __builtin_amdgcn_mfma_f32_16x16x32_bf16(Bt[n][k], At[m][k], acc[ai][bj][m][n], 0, 0, 0); } __builtin_amdgcn_s_setprio(0); } while (0)
#define PG8_MMA0(ai, bj, At, Bt) do { __builtin_amdgcn_s_setprio(1); _Pragma("unroll") for (int m = 0; m < 4; ++m) _Pragma("unroll") for (int n = 0; n < 2; ++n) { \
        if constexpr (F8) { acc[ai][bj][m][n] = __builtin_bit_cast(f32x4, __builtin_amdgcn_mfma_i32_16x16x64_i8(__builtin_bit_cast(i32x4, Bt[n][0]), __builtin_bit_cast(i32x4, At[m][0]), (i32x4){0, 0, 0, 0}, 0, 0, 0)); \
                            acc[ai][bj][m][n] = __builtin_bit_cast(f32x4, __builtin_amdgcn_mfma_i32_16x16x64_i8(__builtin_bit_cast(i32x4, Bt[n][1]), __builtin_bit_cast(i32x4, At[m][1]), __builtin_bit_cast(i32x4, acc[ai][bj][m][n]), 0, 0, 0)); } \
        else { acc[ai][bj][m][n] = __builtin_amdgcn_mfma_f32_16x16x32_bf16(Bt[n][0], At[m][0], (f32x4){0.f, 0.f, 0.f, 0.f}, 0, 0, 0); acc[ai][bj][m][n] = __builtin_amdgcn_mfma_f32_16x16x32_bf16(Bt[n][1], At[m][1], acc[ai][bj][m][n], 0, 0, 0); } } \
        __builtin_amdgcn_s_setprio(0); } while (0)
#define PG8_WAIT_V(n) asm volatile("s_waitcnt vmcnt(" #n ")" ::: "memory")
#define PG8_WAIT_L(n) asm volatile("s_waitcnt lgkmcnt(" #n ")" ::: "memory")
#define PG8_BAR __builtin_amdgcn_s_barrier()
#define PG8_SCHED __builtin_amdgcn_sched_barrier(0)
    Unit cur, nxt; int ui = 0;
    if (!S.next(0, cur)) return;
    f32x4 acc[2][2][4][2];
    if constexpr (Epi::CHAIN || !SP2) {
#pragma unroll
    for (int a = 0; a < 2; ++a)
#pragma unroll
        for (int b = 0; b < 2; ++b)
#pragma unroll
            for (int m = 0; m < 4; ++m)
#pragma unroll
                for (int n = 0; n < 2; ++n) acc[a][b][m][n] = (f32x4){0.f, 0.f, 0.f, 0.f};
    }
    bf16x8 At[4][2], B0[2][2], B1[2][2];
    unsigned cA = baseA + (unsigned)cur.pm * tstepA + (unsigned)cur.kb * kbstep + (unsigned)cur.k0 * kstep, cB = baseB + (unsigned)cur.pn * tstepB + (unsigned)cur.kb * kbstep + (unsigned)cur.k0 * kstep;
    S.a_ready(cur);
    if constexpr (SP2) {
        PG8_STAGE(PG8_SB(0, 0), cB, voffB); PG8_STAGE(PG8_SB(0, 1), cB + hstepB, voffB); PG8_STAGE(PG8_SA(0, 0), cA, voffA); PG8_STAGE(PG8_SA(0, 1), cA + hstepA, voffA);
        if (wr == 1) PG8_BAR;
        PG8_WAIT_V(2); PG8_BAR;
        PG8_STAGE(PG8_SB(1, 0), cB + kstep, voffB); PG8_STAGE(PG8_SA(1, 0), cA + kstep, voffA); PG8_STAGE(PG8_SB(1, 1), cB + hstepB + kstep, voffB);
        PG8_WAIT_V(6); PG8_BAR;
    } else {
        PG8_STAGE(PG8_SB(0, 0), cB, voffB); PG8_STAGE(PG8_SA(0, 0), cA, voffA); PG8_STAGE(PG8_SB(0, 1), cB + hstepB, voffB); PG8_STAGE(PG8_SA(0, 1), cA + hstepA, voffA);
        if (wr == 1) PG8_BAR;
        PG8_WAIT_V(4); PG8_BAR;
        PG8_STAGE(PG8_SB(1, 0), cB + kstep, voffB); PG8_STAGE(PG8_SA(1, 0), cA + kstep, voffA); PG8_STAGE(PG8_SB(1, 1), cB + hstepB + kstep, voffB);
        PG8_WAIT_V(6); PG8_BAR;
    }
    for (;;) {
        const bool has_next = S.next(ui + 1, nxt);
        const unsigned nA = has_next ? baseA + (unsigned)nxt.pm * tstepA + (unsigned)nxt.kb * kbstep + (unsigned)nxt.k0 * kstep : cA, nB = has_next ? baseB + (unsigned)nxt.pn * tstepB + (unsigned)nxt.kb * kbstep + (unsigned)nxt.k0 * kstep : cB;
        const int nt = cur.nkt;
        int t = 0;
        if constexpr (SP2 && !Epi::CHAIN) {
            const unsigned a1 = cA + kstep, a2 = cA + 2u * kstep, b2 = cB + 2u * kstep, a3 = a2 + kstep, b3 = b2 + kstep;
            PG8_LDB(B0, 0, 0); PG8_LDB(B1, 0, 1); PG8_SCHED; PG8_LDA(At, 0, 0); PG8_STAGE(PG8_SA(1, 1), a1 + hstepA, voffA);
            PG8_WAIT_V(8); PG8_WAIT_L(0); PG8_BAR; PG8_MMA0(0, 0, At, B0); PG8_MMA0(0, 1, At, B1); PG8_BAR; PG8_SCHED;
            PG8_LDA(At, 0, 1); PG8_STAGE(PG8_SB(0, 0), b2, voffB); PG8_STAGE(PG8_SB(0, 1), b2 + hstepB, voffB); PG8_STAGE(PG8_SA(0, 0), a2, voffA);
            PG8_WAIT_V(8); PG8_WAIT_L(0); PG8_BAR; PG8_MMA0(1, 0, At, B0); PG8_MMA0(1, 1, At, B1); PG8_BAR; PG8_SCHED;
            PG8_LDB(B0, 1, 0); PG8_LDB(B1, 1, 1); PG8_SCHED; PG8_LDA(At, 1, 0); PG8_STAGE(PG8_SA(0, 1), a2 + hstepA, voffA);
            PG8_WAIT_V(8); PG8_WAIT_L(0); PG8_BAR; PG8_MMA(0, 0, At, B0); PG8_MMA(0, 1, At, B1); PG8_BAR; PG8_SCHED;
            PG8_LDA(At, 1, 1); PG8_STAGE(PG8_SB(1, 0), b3, voffB); PG8_STAGE(PG8_SB(1, 1), b3 + hstepB, voffB); PG8_STAGE(PG8_SA(1, 0), a3, voffA);
            PG8_WAIT_V(8); PG8_WAIT_L(0); PG8_BAR; PG8_MMA(1, 0, At, B0); PG8_MMA(1, 1, At, B1); PG8_BAR; PG8_SCHED;
            t = 2;
        }
        for (; t < nt; t += 2) {
            const bool last = (t == nt - 2);
            const unsigned a1 = cA + (unsigned)(t + 1) * kstep;
            const unsigned a2 = last ? nA : cA + (unsigned)(t + 2) * kstep, b2 = last ? nB : cB + (unsigned)(t + 2) * kstep;
            const unsigned a3 = a2 + kstep, b3 = b2 + kstep;
            if (last && has_next) S.a_ready(nxt);
            if constexpr (SP2) {
            PG8_LDB(B0, 0, 0); PG8_LDB(B1, 0, 1); PG8_SCHED; PG8_LDA(At, 0, 0); PG8_STAGE(PG8_SA(1, 1), a1 + hstepA, voffA);
            PG8_WAIT_V(8); PG8_WAIT_L(0); PG8_BAR; PG8_MMA(0, 0, At, B0); PG8_MMA(0, 1, At, B1); PG8_BAR; PG8_SCHED;
            PG8_LDA(At, 0, 1); PG8_STAGE(PG8_SB(0, 0), b2, voffB); PG8_STAGE(PG8_SB(0, 1), b2 + hstepB, voffB); PG8_STAGE(PG8_SA(0, 0), a2, voffA);
            PG8_WAIT_V(8); PG8_WAIT_L(0); PG8_BAR; PG8_MMA(1, 0, At, B0); PG8_MMA(1, 1, At, B1); PG8_BAR; PG8_SCHED;
            PG8_LDB(B0, 1, 0); PG8_LDB(B1, 1, 1); PG8_SCHED; PG8_LDA(At, 1, 0); PG8_STAGE(PG8_SA(0, 1), a2 + hstepA, voffA);
            PG8_WAIT_V(8); PG8_WAIT_L(0); PG8_BAR; PG8_MMA(0, 0, At, B0); PG8_MMA(0, 1, At, B1); PG8_BAR; PG8_SCHED;
            PG8_LDA(At, 1, 1); PG8_STAGE(PG8_SB(1, 0), b3, voffB); PG8_STAGE(PG8_SB(1, 1), b3 + hstepB, voffB); PG8_STAGE(PG8_SA(1, 0), a3, voffA);
            PG8_WAIT_V(8); PG8_WAIT_L(0); PG8_BAR; PG8_MMA(1, 0, At, B0); PG8_MMA(1, 1, At, B1); PG8_BAR; PG8_SCHED;
            } else {
            PG8_LDB(B0, 0, 0); PG8_SCHED; PG8_LDA(At, 0, 0); PG8_STAGE(PG8_SA(1, 1), a1 + hstepA, voffA);
            PG8_WAIT_L(8); PG8_BAR; PG8_WAIT_L(0); PG8_MMA(0, 0, At, B0); PG8_BAR; PG8_SCHED;
            PG8_LDB(B1, 0, 1); PG8_STAGE(PG8_SB(0, 0), b2, voffB);
            PG8_BAR; PG8_WAIT_L(0); PG8_MMA(0, 1, At, B1); PG8_BAR;
            PG8_LDA(At, 0, 1); PG8_STAGE(PG8_SA(0, 0), a2, voffA);
            PG8_BAR; PG8_WAIT_L(0); PG8_MMA(1, 0, At, B0); PG8_BAR; PG8_SCHED;
            PG8_STAGE(PG8_SB(0, 1), b2 + hstepB, voffB);
            PG8_WAIT_V(6); PG8_BAR; PG8_MMA(1, 1, At, B1); PG8_BAR;
            PG8_LDB(B0, 1, 0); PG8_SCHED; PG8_LDA(At, 1, 0); PG8_STAGE(PG8_SA(0, 1), a2 + hstepA, voffA);
            PG8_WAIT_L(8); PG8_BAR; PG8_WAIT_L(0); PG8_MMA(0, 0, At, B0); PG8_BAR; PG8_SCHED;
            PG8_LDB(B1, 1, 1); PG8_STAGE(PG8_SB(1, 0), b3, voffB);
            PG8_BAR; PG8_WAIT_L(0); PG8_MMA(0, 1, At, B1); PG8_BAR;
            PG8_LDA(At, 1, 1); PG8_STAGE(PG8_SA(1, 0), a3, voffA);
            PG8_BAR; PG8_WAIT_L(0); PG8_MMA(1, 0, At, B0); PG8_BAR; PG8_SCHED;
            PG8_STAGE(PG8_SB(1, 1), b3 + hstepB, voffB);
            PG8_WAIT_V(6); PG8_BAR; PG8_MMA(1, 1, At, B1); PG8_BAR;
            }
        }
        if constexpr (ALIGN_EPI) { if (wr == 0) PG8_BAR; }
        if constexpr (!Epi::AFTER_DRAIN) { E(acc, cur, wr, wc, fr, fq); S.done(cur); }
        if (!has_next) break;
        if ((Epi::CHAIN || !SP2) && (!Epi::CHAIN || cur.kb == 2)) {
#pragma unroll
        for (int a = 0; a < 2; ++a)
#pragma unroll
            for (int b = 0; b < 2; ++b)
#pragma unroll
                for (int m = 0; m < 4; ++m)
#pragma unroll
                    for (int n = 0; n < 2; ++n) acc[a][b][m][n] = (f32x4){0.f, 0.f, 0.f, 0.f};
        }
        cur = nxt; cA = nA; cB = nB; ++ui;
        if constexpr (ALIGN_EPI) { if (wr == 1) PG8_BAR; }
    }
    PG8_WAIT_V(0);
    if constexpr (!ALIGN_EPI) { if (wr == 0) PG8_BAR; }
    PG8_BAR;
    if constexpr (Epi::AFTER_DRAIN) { E.fused(acc, cur, wr, wc, fr, fq, lds, wid, lane); S.done(cur); }
#undef PG8_SA
#undef PG8_SB
#undef PG8_STAGE
#undef PG8_LDA
#undef PG8_LDB
#undef PG8_MMA
#undef PG8_MMA0
#undef PG8_WAIT_V
#undef PG8_WAIT_L
#undef PG8_BAR
#undef PG8_SCHED
}
}


constexpr int DM = 2048, DIN = 6144, DFF = 5632, DEPTH = 4;
constexpr int MP = 16384, NSB = 32, LSQ = 32, M = MP + NSB * LSQ;
constexpr int WM = 1024;
constexpr int OFF_BG = 0, OFF_CG = 1024, OFF_HC = 2048, OFF_US = 3072, OFF_UG = 4096, OFF_VG = 5120;
constexpr int QMODE = 2;
constexpr int NB16 = QMODE == 0 ? 16 : QMODE == 1 ? 12 : 8, NH8 = 24 - NB16;
__host__ __device__ constexpr int h_tile16(int i) { return QMODE == 0 ? ((i >= 12 && i < 16) ? i + 4 : (i >= 16 && i < 20) ? i - 4 : i) : QMODE == 1 ? i : (i < 8 ? i + 4 : i < 12 ? i - 8 : i); }
__host__ __device__ constexpr int h_tile8(int j) { return h_tile16(NB16 + j); }
constexpr int SG = 64, SP = 64, SI = 16, CH = 32, NCH = MP / CH;
constexpr float EPS = 1e-6f;
constexpr int NWAVES = 8, NTHREADS = NWAVES * 64;

constexpr size_t O_Y = 0;
constexpr size_t O_CONVP = (size_t)M * DM;
constexpr size_t O_SREP = O_CONVP + 4 * 2 * 1024;
constexpr size_t O_SIMP = O_SREP + 4 * 64 * 64;
constexpr size_t O_CONVS = O_SIMP + 4 * 64 * 64;
constexpr size_t O_SRES = O_CONVS + 4 * 32 * 2 * 1024;
constexpr size_t O_SIMS = O_SRES + 4 * 32 * 64 * 64;
constexpr size_t O_VS = O_SIMS + 4 * 32 * 64 * 64;
constexpr size_t O_END = O_VS + (size_t)4 * 32 * 32 * 1024;
static_assert(O_END == 41197568, "output size");

constexpr size_t MiB = 1u << 20;
constexpr size_t WS_CTL = 0, CTL_ZERO_BYTES = 1 * MiB;
constexpr size_t WS_SSMC = 1 * MiB;
constexpr size_t SSMC_LAYER = 576 * 1024, SSMC_LB = 0, SSMC_LBT = 32 * 1024, SSMC_BB = 64 * 1024;
constexpr size_t WS_SSQ = 4 * MiB;
constexpr size_t WS_RSTD = 7 * MiB;
constexpr size_t WS_S8 = 8 * MiB;
constexpr size_t WS_XB = 15 * MiB;
constexpr size_t WS_H = 83 * MiB;
constexpr size_t WS_G = 287 * MiB;
constexpr size_t WS_Y3 = 491 * MiB;
constexpr size_t WS_YS = 593 * MiB, WS_VN = 627 * MiB;
constexpr int Y3W = 3 * WM;
constexpr size_t WS_MG = 661 * MiB;
constexpr size_t WS_XB8 = WS_MG;
constexpr float W8_SCALE = 1408.0f;
constexpr float X8_SCALE = 28.0f;
constexpr size_t WS_E2 = WS_MG;
constexpr size_t WS_W = 729 * MiB, W_LAYER = 136 * MiB;
constexpr size_t W_1 = 0, W_1G = 24 * MiB  , W_M = 48 * MiB  , W_GLU = 60 * MiB, W_O = 62 * MiB, W_F1 = 70 * MiB, W_F2 = 114 * MiB;
constexpr size_t WS_TAB = WS_W + 4 * W_LAYER, TAB_LAYER = 2 * MiB;
constexpr size_t T_BBT = 0, T_CMT = 256 * 1024, T_LPOW = 512 * 1024, T_WSB = 1024 * 1024;
constexpr size_t WS_END = WS_TAB + 4 * TAB_LAYER;
static_assert((size_t)M * DM * 2 == 68 * MiB && (size_t)M * DIN * 2 == 204 * MiB && (size_t)M * WM * 2 == 34 * MiB, "ws map");
static_assert((size_t)M * DFF * 2 <= 204 * MiB && (size_t)M * DM * 4 <= 204 * MiB && (size_t)DFF * DM * 2 == 22 * MiB, "ws map");

constexpr int LDS_BYTES = 147456;
constexpr int RING_BYTES = 131072, MISC_OFF = LDS_BYTES - 256;

enum { I_XP = 0, I_XS, I_CACHE, I_STRE, I_STIM, I_NMIX, I_WIN, I_CONVW, I_WCO, I_LRE, I_LIM, I_LDT, I_BRE, I_BIM, I_CRE, I_CIM, I_SD, I_WGLU, I_BGLU, I_WSO, I_LNV, I_WS, I_BS, I_WGO, I_WGATE, I_BGATE, I_WO, I_NFFN, I_WF1, I_WF2, I_NFIN, N_IN };

#define LAS __attribute__((address_space(3)))
typedef unsigned short bf16;
typedef unsigned v4u __attribute__((ext_vector_type(4)));
typedef unsigned v2u __attribute__((ext_vector_type(2)));
typedef float f32x4 __attribute__((ext_vector_type(4)));
typedef float f32x2 __attribute__((ext_vector_type(2)));
typedef short bf16x8 __attribute__((ext_vector_type(8)));
typedef float f32x16 __attribute__((ext_vector_type(16)));
#define MFMA32(a, b, c) __builtin_amdgcn_mfma_f32_32x32x16_bf16((a), (b), (c), 0, 0, 0)
#define MFMA16(a, b, c) __builtin_amdgcn_mfma_f32_16x16x32_bf16((a), (b), (c), 0, 0, 0)
#define LDS_WAIT() asm volatile("s_waitcnt lgkmcnt(0)" ::: "memory")
#define GAS __attribute__((address_space(1)))
#define LAUNDER_G(p, c) do { GAS unsigned char* g_ = (GAS unsigned char*)(p); asm volatile("" : c(g_)); (p) = (__typeof__((p) + 0))(unsigned char*)g_; } while (0)
#define VM_WAIT() asm volatile("s_waitcnt vmcnt(0)" ::: "memory")

typedef __bf16 bf16x2_t __attribute__((ext_vector_type(2)));
__device__ __forceinline__ unsigned cvt_pk(float lo, float hi) { const f32x2 f = {lo, hi}; return __builtin_bit_cast(unsigned, __builtin_convertvector(f, bf16x2_t)); }
__device__ __forceinline__ float bflo(unsigned w) { return __uint_as_float(w << 16); }
__device__ __forceinline__ float bfhi(unsigned w) { return __uint_as_float(w & 0xffff0000u); }
__device__ __forceinline__ void unpack8(const v4u w, float (&f)[8]) { f[0] = bflo(w.x); f[1] = bfhi(w.x); f[2] = bflo(w.y); f[3] = bfhi(w.y); f[4] = bflo(w.z); f[5] = bfhi(w.z); f[6] = bflo(w.w); f[7] = bfhi(w.w); }
__device__ __forceinline__ v4u pack8(const float (&f)[8]) { v4u w; w.x = cvt_pk(f[0], f[1]); w.y = cvt_pk(f[2], f[3]); w.z = cvt_pk(f[4], f[5]); w.w = cvt_pk(f[6], f[7]); return w; }
__device__ __forceinline__ unsigned q8b(float x, float sc) { const float m = 12582912.0f; return __float_as_uint(__builtin_amdgcn_fmed3f(__builtin_fmaf(x, sc, m), m - 127.0f, m + 127.0f)); }
__device__ __forceinline__ unsigned pack4_i8(float a, float b, float c, float d, float sc) {
    const unsigned w01 = __builtin_amdgcn_perm(q8b(b, sc), q8b(a, sc), 0x0c0c0400u), w23 = __builtin_amdgcn_perm(q8b(d, sc), q8b(c, sc), 0x0c0c0400u); return w01 | (w23 << 16); }
__device__ __forceinline__ float sigmoid_f(float v) { return __builtin_amdgcn_rcpf(1.0f + __builtin_amdgcn_exp2f(-1.44269504f * v)); }
__device__ __forceinline__ float gelu_t(float x) { return x * sigmoid_f(1.5957691216f * x * (1.0f + 0.044715f * x * x)); }
__device__ __forceinline__ float wave_sum(float v) {
#pragma unroll
    for (int o = 1; o < 64; o <<= 1) v += __shfl_xor(v, o);
    return v;
}

__device__ __forceinline__ int lane_id_opaque() { unsigned z = 0u; asm volatile("" : "+s"(z)); return (int)__builtin_amdgcn_mbcnt_hi(~0u, __builtin_amdgcn_mbcnt_lo(~0u, z)); }
#define XB_TMO      128
#define XB_XCNT(j)  (256  + 64 * (j))
#define XB_XSUB(j)  (1280 + 64 * (j))
#define XB_XGEN(j)  (2304 + 64 * (j))
#define XB_TOP      3328
#define XB_TOPGEN   3392
#define XCD_BAR_WORDS 3456
#define XB_SPIN_CAP (1u << 22)

__device__ __forceinline__ unsigned xb_ld(unsigned* p)              { return __hip_atomic_load(p, __ATOMIC_RELAXED, __HIP_MEMORY_SCOPE_AGENT); }
__device__ __forceinline__ unsigned xb_add(unsigned* p, unsigned v) { return __hip_atomic_fetch_add(p, v, __ATOMIC_RELAXED, __HIP_MEMORY_SCOPE_AGENT); }
__device__ __forceinline__ unsigned xb_xcc_id() { return (unsigned)__builtin_amdgcn_s_getreg((3 << 11) | 20) & 0xFu; }
#define XB_SPIN(cond, bar) do { unsigned _sp = 0; while (cond) { __builtin_amdgcn_s_sleep(1); \
    if ((++_sp & 255u) == 0u) { if (xb_ld(&(bar)[XB_TMO])) break; if (_sp > XB_SPIN_CAP) { atomicAdd(&(bar)[XB_TMO], 1u); break; } } } } while (0)

struct XcdBarrier { unsigned* bar; unsigned x; volatile LAS unsigned* st; unsigned wave; };

__device__ __forceinline__ XcdBarrier xcd_barrier_post(unsigned* bar, volatile LAS unsigned* st, unsigned wave) {
    XcdBarrier b; b.bar = bar; b.x = xb_xcc_id(); b.st = st; b.wave = wave;
    if (wave == 0u && lane_id_opaque() == 0) (void)xb_add(&bar[XB_XCNT(b.x)], 1u);
    return b;
}
__device__ __forceinline__ void xcd_barrier_complete(unsigned* bar, unsigned x, unsigned& nloc, unsigned& nx) {
    const unsigned G = gridDim.x * gridDim.y * gridDim.z;
    unsigned sum, cnt, mine, sp = 0u;
    for (;;) {
        sum = 0u; cnt = 0u; mine = 0u;
#pragma unroll
        for (unsigned j = 0; j < 16; ++j) { const unsigned c = xb_ld(&bar[XB_XCNT(j)]); sum += c; cnt += (c > 0u) ? 1u : 0u; mine = (j == x) ? c : mine; }
        if (sum == G) break;
        __builtin_amdgcn_s_sleep(1);
        if ((++sp & 255u) == 0u) { if (xb_ld(&bar[XB_TMO])) break; if (sp > XB_SPIN_CAP) { atomicAdd(&bar[XB_TMO], 1u); break; } }
    }
    nloc = mine > 0u ? mine : 1u; nx = cnt > 0u ? cnt : 1u;
}
__device__ __forceinline__ void xcd_barrier(const XcdBarrier& b) {
    asm volatile("s_waitcnt vmcnt(0)" ::: "memory");
    __syncthreads();
    if (b.wave == 0u && lane_id_opaque() == 0) {
        unsigned* bar = b.bar; unsigned bx = b.x; LAUNDER_G(bar, "+s"); asm volatile("" : "+s"(bx));
        __builtin_amdgcn_s_waitcnt(0);
        unsigned nloc = b.st[0], nx = b.st[1];
        if (nloc == 0u) { xcd_barrier_complete(bar, bx, nloc, nx); b.st[0] = nloc; b.st[1] = nx; }
        const unsigned old = xb_add(&bar[XB_XSUB(bx)], 1u);
        const unsigned gen = old / nloc;
        if (old + 1u == (gen + 1u) * nloc) {
            __builtin_amdgcn_fence(__ATOMIC_RELEASE, "agent");
            asm volatile("s_waitcnt vmcnt(0)" ::: "memory");
            const unsigned og = xb_add(&bar[XB_TOP], 1u);
            const unsigned tg = og / nx;
            if (og + 1u == (tg + 1u) * nx) xb_add(&bar[XB_TOPGEN], 1u);
            else XB_SPIN(xb_ld(&bar[XB_TOPGEN]) == tg, bar);
            __builtin_amdgcn_fence(__ATOMIC_ACQUIRE, "agent");
            xb_add(&bar[XB_XGEN(bx)], 1u);
            asm volatile("s_waitcnt vmcnt(0)" ::: "memory");
        } else {
            XB_SPIN(xb_ld(&bar[XB_XGEN(bx)]) == gen, bar);
            __builtin_amdgcn_fence(__ATOMIC_ACQUIRE, "agent");
            asm volatile("s_waitcnt vmcnt(0)" ::: "memory");
        }
    }
    __syncthreads();
}

struct Frame {
    LAS unsigned char* lds;
    int tid, lane, wave, vcu, G;
    float* out;
    unsigned char* ws;
};
#define WSP(T, off) ((T*)(F.ws + (off)))
#define SITE(Fs) Frame F = Fs; LAUNDER_G(F.ws, "+s"); LAUNDER_G(F.out, "+s"); asm volatile("" : "+s"(F.wave)); F.lane = lane_id_opaque(); F.tid = F.wave * 64 + F.lane
struct Args { const float* in[N_IN]; float* out; unsigned char* ws; int ph_lo, ph_hi; };
static_assert(sizeof(Args) == N_IN * 8 + 24, "Args has no padding");
typedef const __attribute__((address_space(4))) Args KArgs;
#define KARGS() KArgs* kargs = (KArgs*)__builtin_amdgcn_kernarg_segment_ptr(); asm volatile("" : "+s"(kargs))
#define INP(i) (kargs->in[i])

using pg8::Unit;
typedef pg8::f32x4 A4;

__device__ __forceinline__ void row_rstd(const float* ssq, int row0, int fq, float (&rs)[2][4], const float* rstd = nullptr) {
    if (rstd) {
#pragma unroll
        for (int ai = 0; ai < 2; ++ai)
#pragma unroll
            for (int m = 0; m < 4; ++m) rs[ai][m] = rstd[row0 + ai * 128 + m * 16];
        return; }
#pragma unroll
    for (int ai = 0; ai < 2; ++ai)
#pragma unroll
        for (int m = 0; m < 4; ++m) {
            const f32x4* p = (const f32x4*)(ssq + (size_t)(row0 + ai * 128 + m * 16) * 32 + fq * 8);
            const f32x4 a = p[0], b = p[1];
            float s = ((a.x + a.y) + (a.z + a.w)) + ((b.x + b.y) + (b.z + b.w));
            s += __shfl_xor(s, 16); s += __shfl_xor(s, 32);
            rs[ai][m] = rsqrtf(s * (1.0f / DM) + EPS);
        }
}

struct EpiH {
    static constexpr bool PERM = true, AFTER_DRAIN = false, CHAIN = false;
    bf16* H; const float* ssq; const float* rstd;
    __device__ __forceinline__ void operator()(const A4 (&acc)[2][2][4][2], const Unit& u, int wr, int wc, int fr, int fq) const {
        const int row0 = u.pm * 256 + wr * 64 + fr;
        float rs[2][4]; row_rstd(ssq, row0, fq, rs, u.pm < MP / 256 ? rstd : nullptr);
        const int ht = h_tile16(u.pn); const bool zt = ht >= OFF_CG / 256 && ht < OFF_US / 256;
        const int colt = ht * 256 + wc * 32 + 8 * fq;
#pragma unroll
        for (int ai = 0; ai < 2; ++ai)
#pragma unroll
            for (int m = 0; m < 4; ++m) {
                const float r = rs[ai][m];
                if (zt) {
                    float f[8];
#pragma unroll
                    for (int n = 0; n < 2; ++n)
#pragma unroll
                        for (int j = 0; j < 4; ++j) f[4 * n + j] = (acc[ai][0][m][n][j] * r) * (acc[ai][1][m][n][j] * r);
                    *(v4u*)(H + (size_t)(row0 + ai * 128 + m * 16) * DIN + OFF_CG + 128 * (ht - OFF_CG / 256) + wc * 32 + 8 * fq) = pack8(f);
                } else {
                    bf16* rowp = H + (size_t)(row0 + ai * 128 + m * 16) * DIN + colt;
#pragma unroll
                    for (int bj = 0; bj < 2; ++bj) {
                        float f[8];
#pragma unroll
                        for (int n = 0; n < 2; ++n)
#pragma unroll
                            for (int j = 0; j < 4; ++j) f[4 * n + j] = acc[ai][bj][m][n][j] * r;
                        *(v4u*)(rowp + bj * 128) = pack8(f);
                    }
                }
            }
    }
};
struct EpiG8 {
    static constexpr bool PERM = true, AFTER_DRAIN = false, CHAIN = false;
    bf16* H; bf16* Gt; const float* ssq; const float* bgate; const float* rstd; const float* s8;
    __device__ __forceinline__ void operator()(const A4 (&acc)[2][2][4][2], const Unit& u, int wr, int wc, int fr, int fq) const {
        { const int ln = lane_id_opaque(); fr = ln & 15; fq = ln >> 4; }
        const int row0 = u.pm * 256 + wr * 64 + fr;
        float rs[2][4]; row_rstd(ssq, row0, fq, rs, u.pm < MP / 256 ? rstd : nullptr);
#pragma unroll
        for (int ai = 0; ai < 2; ++ai)
#pragma unroll
            for (int m = 0; m < 4; ++m) rs[ai][m] *= (1.0f / W8_SCALE) * __builtin_amdgcn_rcpf(s8[row0 + ai * 128 + m * 16]);
        if (u.pn < NH8) {
            const int colt = h_tile8(u.pn) * 256 + wc * 32 + 8 * fq;
#pragma unroll
            for (int ai = 0; ai < 2; ++ai)
#pragma unroll
                for (int m = 0; m < 4; ++m) {
                    const float r = rs[ai][m]; bf16* rowp = H + (size_t)(row0 + ai * 128 + m * 16) * DIN + colt;
#pragma unroll
                    for (int bj = 0; bj < 2; ++bj) {
                        float f[8];
#pragma unroll
                        for (int n = 0; n < 2; ++n)
#pragma unroll
                            for (int j = 0; j < 4; ++j) f[4 * n + j] = (float)__float_as_int(acc[ai][bj][m][n][j]) * r;
                        *(v4u*)(rowp + bj * 128) = pack8(f);
                    }
                }
            return;
        }
        const int gn = u.pn - NH8, tid = (wr * 4 + wc) * 64 + fq * 16 + fr, colt = gn * 256 + wc * 32 + 8 * fq;
        f32x4 bv[2][2];
#pragma unroll
        for (int bj = 0; bj < 2; ++bj)
#pragma unroll
            for (int n = 0; n < 2; ++n) bv[bj][n] = *(const f32x4*)(bgate + colt + bj * 128 + 4 * n) * -1.44269504f - 8.0f;
#pragma unroll
        for (int ai = 0; ai < 2; ++ai)
#pragma unroll
            for (int m = 0; m < 4; ++m) {
                const float r = rs[ai][m] * -1.44269504f;
                unsigned q[4] = {0u, 0u, 0u, 0u};
#pragma unroll
                for (int bj = 0; bj < 2; ++bj)
#pragma unroll
                    for (int n = 0; n < 2; ++n) {
                        unsigned w = 0u;
#pragma unroll
                        for (int j = 0; j < 4; ++j) w = __builtin_amdgcn_cvt_pk_u8_f32(floorf(__builtin_amdgcn_rcpf(__builtin_amdgcn_exp2f(__builtin_fmaf((float)__float_as_int(acc[ai][bj][m][n][j]), r, bv[bj][n][j])) + 0.00390625f)), j, w);
                        q[2 * bj + n] = w;
                    }
                *(v4u*)((unsigned char*)Gt + ((size_t)(u.pm * 24 + gn) * 8 + ai * 4 + m) * 8192 + (size_t)tid * 16) = (v4u){q[0], q[1], q[2], q[3]};
            }
    }
};
__device__ __forceinline__ const v4u* gt_ptr(const bf16* Gt, int pm, int gn, int ai, int m, int tid) { return (const v4u*)((const unsigned char*)Gt + ((size_t)(pm * 24 + gn) * 8 + ai * 4 + m) * 8192 + (size_t)tid * 16); }
__device__ __forceinline__ void gate_unpack(const v4u w, float (&g)[2][8]) {
    const unsigned q[4] = {w.x, w.y, w.z, w.w};
#pragma unroll
    for (int i = 0; i < 4; ++i)
#pragma unroll
        for (int b = 0; b < 4; ++b) g[i >> 1][4 * (i & 1) + b] = ((float)((q[i] >> (8 * b)) & 0xffu) + 0.5f) * (1.0f / 256.0f);
}
constexpr size_t SLAB = 65536;
struct EpiGLU {
    static constexpr bool PERM = true, AFTER_DRAIN = false, CHAIN = false;
    const bf16* YS; bf16* YS2; const float* bias; const bf16* slab;
    __device__ __forceinline__ void group(const A4 (&a)[2][2], const f32x4 (&bv)[2][2], int row, int col0) const {
#pragma unroll
        for (int bj = 0; bj < 2; ++bj) {
            float y[8], f[8]; unpack8(*(const v4u*)(YS + (size_t)row * WM + col0 + bj * 128), y);
#pragma unroll
            for (int n = 0; n < 2; ++n)
#pragma unroll
                for (int j = 0; j < 4; ++j) f[4 * n + j] = y[4 * n + j] * sigmoid_f(a[bj][n][j] + bv[bj][n][j]);
            *(v4u*)(YS2 + (size_t)row * Y3W + col0 + bj * 128) = pack8(f);
        }
    }
    __device__ __forceinline__ void operator()(const A4 (&acc)[2][2][4][2], const Unit& u, int wr, int wc, int fr, int fq) const {
        { const int ln = lane_id_opaque(); fr = ln & 15; fq = ln >> 4; }
        const int row0 = u.pm * 256 + wr * 64 + fr, col0 = u.pn * 256 + wc * 32 + 8 * fq;
        f32x4 bv[2][2];
#pragma unroll
        for (int bj = 0; bj < 2; ++bj)
#pragma unroll
            for (int n = 0; n < 2; ++n) bv[bj][n] = *(const f32x4*)(bias + col0 + bj * 128 + 4 * n);
#pragma unroll
        for (int ai = 0; ai < 2; ++ai)
#pragma unroll
            for (int m = 0; m < 4; ++m) {
                const A4 a[2][2] = {{acc[ai][0][m][0], acc[ai][0][m][1]}, {acc[ai][1][m][0], acc[ai][1][m][1]}};
                group(a, bv, row0 + ai * 128 + m * 16, col0);
                asm volatile("" ::: "memory");
            }
    }
    __device__ __forceinline__ void reduce(int ts, int grp, int tid) const {
        asm volatile("" : "+v"(tid));
        const int wid = tid >> 6, lane = tid & 63, wr = wid >> 2, wc = wid & 3, fr = lane & 15, fq = lane >> 4, ai = grp >> 2, m = grp & 3;
        const int row = (MP / 256 + (ts >> 2)) * 256 + ai * 128 + wr * 64 + m * 16 + fr, col0 = (ts & 3) * 256 + wc * 32 + 8 * fq;
        A4 a[2][2]; f32x4 bv[2][2];
#pragma unroll
        for (int bj = 0; bj < 2; ++bj) { const bf16* p = slab + (size_t)(ts * 4) * SLAB + (size_t)(grp * 2 + bj) * 4096 + (size_t)tid * 8; float t[8]; unpack8(*(const v4u*)p, t);
#pragma unroll
            for (int sl = 1; sl < 4; ++sl) { p += SLAB; LAUNDER_G(p, "+v"); float x[8]; unpack8(*(const v4u*)p, x);
#pragma unroll
                for (int j = 0; j < 8; ++j) t[j] += x[j]; }
            a[bj][0] = (A4){t[0], t[1], t[2], t[3]}; a[bj][1] = (A4){t[4], t[5], t[6], t[7]};
            bv[bj][0] = *(const f32x4*)(bias + col0 + bj * 128); bv[bj][1] = *(const f32x4*)(bias + col0 + bj * 128 + 4); }
        group(a, bv, row, col0);
    }
};
__device__ __forceinline__ void store_slab(const A4 (&acc)[2][2][4][2], bf16* slab, int tid) {
    bf16* p = slab + (size_t)tid * 8;
#pragma unroll
    for (int ai = 0; ai < 2; ++ai)
#pragma unroll
        for (int m = 0; m < 4; ++m)
#pragma unroll
            for (int bj = 0; bj < 2; ++bj) { const float f[8] = {acc[ai][bj][m][0][0], acc[ai][bj][m][0][1], acc[ai][bj][m][0][2], acc[ai][bj][m][0][3], acc[ai][bj][m][1][0], acc[ai][bj][m][1][1], acc[ai][bj][m][1][2], acc[ai][bj][m][1][3]};
                *(v4u*)p = pack8(f); p += 4096; LAUNDER_G(p, "+v"); }
}
struct EpiSlab {
    static constexpr bool PERM = true, AFTER_DRAIN = false, CHAIN = false;
    bf16* slab; int per, npn;
    __device__ __forceinline__ void operator()(const A4 (&acc)[2][2][4][2], const Unit& u, int wr, int wc, int fr, int fq) const {
        store_slab(acc, slab + (size_t)((((u.pm - MP / 256) * npn + u.pn) * per) + u.part) * SLAB, (wr * 4 + wc) * 64 + fq * 16 + fr); }
};
struct EpiMrgC {
    static constexpr bool PERM = true, AFTER_DRAIN = false, CHAIN = true;
    const bf16* Gt; bf16* MG; bf16* slab;
    __device__ __forceinline__ void operator()(A4 (&acc)[2][2][4][2], const Unit& u, int wr, int wc, int fr, int fq) const {
        const int row0 = u.pm * 256 + wr * 64 + fr, col0 = u.pn * 256 + wc * 32 + 8 * fq, tid = (wr * 4 + wc) * 64 + fq * 16 + fr;
        const __amdgpu_buffer_rsrc_t rs = __builtin_amdgcn_make_buffer_rsrc((void*)Gt, (short)0, 0x7fffffff, 0x00020000);
        const int vo = tid * 16, so = ((u.pm * 24 + u.kb * 8 + u.pn) * 8) * 8192;
#pragma unroll
        for (int ai = 0; ai < 2; ++ai) {
            v4u gw[4], gnw[4];
#pragma unroll
            for (int m = 0; m < 4; ++m) gw[m] = __builtin_bit_cast(v4u, __builtin_amdgcn_raw_buffer_load_b128(rs, vo, so + (ai * 4 + m) * 8192, 0));
            if (u.kb < 2) {
#pragma unroll
                for (int m = 0; m < 4; ++m) gnw[m] = __builtin_bit_cast(v4u, __builtin_amdgcn_raw_buffer_load_b128(rs, vo, so + (64 + ai * 4 + m) * 8192, 0));
#pragma unroll
                for (int m = 0; m < 4; ++m) {
                    const unsigned q[4] = {gw[m].x, gw[m].y, gw[m].z, gw[m].w}, qn[4] = {gnw[m].x, gnw[m].y, gnw[m].z, gnw[m].w};
#pragma unroll
                    for (int i = 0; i < 4; ++i)
#pragma unroll
                        for (int b = 0; b < 4; ++b) acc[ai][i >> 1][m][i & 1][b] *= ((float)((q[i] >> (8 * b)) & 0xffu) + 0.5f) * __builtin_amdgcn_rcpf((float)((qn[i] >> (8 * b)) & 0xffu) + 0.5f);
                }
            } else {
#pragma unroll
                for (int m = 0; m < 4; ++m) {
                    const int row = row0 + ai * 128 + m * 16;
                    float g[2][8]; gate_unpack(gw[m], g);
#pragma unroll
                    for (int bj = 0; bj < 2; ++bj) {
                        float f[8];
#pragma unroll
                        for (int j = 0; j < 4; ++j) { f[j] = g[bj][j] * acc[ai][bj][m][0][j]; f[4 + j] = g[bj][4 + j] * acc[ai][bj][m][1][j]; }
                        *(v4u*)(MG + (size_t)row * DM + col0 + bj * 128) = pack8(f);
                    }
                }
            }
            asm volatile("" ::: "memory");
        }
    }
    __device__ __forceinline__ void reduce(int ts, int grp, int tid) const {
        asm volatile("" : "+v"(tid));
        const int wid = tid >> 6, lane = tid & 63, wr = wid >> 2, wc = wid & 3, fr = lane & 15, fq = lane >> 4, ai = grp >> 2, m = grp & 3;
        const int row = (MP / 256 + (ts >> 3)) * 256 + ai * 128 + wr * 64 + m * 16 + fr, col0 = (ts & 7) * 256 + wc * 32 + 8 * fq;
        float g[3][2][8];
#pragma unroll
        for (int b = 0; b < 3; ++b) gate_unpack(*gt_ptr(Gt, MP / 256 + (ts >> 3), b * 8 + (ts & 7), ai, m, tid), g[b]);
#pragma unroll
        for (int bj = 0; bj < 2; ++bj) {
            float f[8];
#pragma unroll
            for (int j = 0; j < 8; ++j) f[j] = 0.f;
#pragma unroll
            for (int b = 0; b < 3; ++b) {
                { const size_t off = (size_t)(grp * 2 + bj) * 4096 + (size_t)tid * 8; float p0[8], p1[8];
                    unpack8(*(const v4u*)(slab + (size_t)(ts * 6 + 2 * b) * SLAB + off), p0); unpack8(*(const v4u*)(slab + (size_t)(ts * 6 + 2 * b + 1) * SLAB + off), p1);
#pragma unroll
                    for (int j = 0; j < 8; ++j) f[j] += g[b][bj][j] * (p0[j] + p1[j]); }
            }
            *(v4u*)(MG + (size_t)row * DM + col0 + bj * 128) = pack8(f);
        }
    }
};
template <int MODE> struct EpiRes {
    static constexpr bool PERM = true, AFTER_DRAIN = false, CHAIN = false;
    float* X; bf16* XB; float* ssq; bf16* slab; int dry;
    const float* XinP; const float* XinS; int first;
    unsigned char* XB8; const float* s8;
    __device__ __forceinline__ void xload(A4 (&x)[2][2], int row, int col0) const {
        if (MODE == 0 && first) { const float* xi = (row < MP ? XinP : XinS) + (size_t)row * DM + col0;
#pragma unroll
            for (int bj = 0; bj < 2; ++bj) { x[bj][0] = *(const f32x4*)(xi + bj * 128); x[bj][1] = *(const f32x4*)(xi + bj * 128 + 4); }
        } else {
#pragma unroll
            for (int bj = 0; bj < 2; ++bj) { float t[8]; unpack8(*(const v4u*)(XB + (size_t)row * DM + col0 + bj * 128), t); x[bj][0] = (A4){t[0], t[1], t[2], t[3]}; x[bj][1] = (A4){t[4], t[5], t[6], t[7]}; } }
    }
    __device__ __forceinline__ void group(const A4 (&a)[2][2], const A4 (&x)[2][2], int row, int col0, int pn, int wc, int fq, float sc = 0.f) const {
        float s = 0.f;
#pragma unroll
        for (int bj = 0; bj < 2; ++bj) {
            float f[8];
#pragma unroll
            for (int j = 0; j < 4; ++j) { f[j] = x[bj][0][j] + a[bj][0][j]; f[4 + j] = x[bj][1][j] + a[bj][1][j]; }
#pragma unroll
            for (int j = 0; j < 8; ++j) s += f[j] * f[j];
            if (DUPMASK && dry) { asm volatile("" :: "v"(f[0]), "v"(f[7])); continue; }
            *(v4u*)(XB + (size_t)row * DM + col0 + bj * 128) = pack8(f);
            if (MODE == 1) *(v2u*)(XB8 + (size_t)row * DM + col0 + bj * 128) = (v2u){pack4_i8(f[0], f[1], f[2], f[3], sc), pack4_i8(f[4], f[5], f[6], f[7], sc)};
        }
        s += __shfl_xor(s, 16); s += __shfl_xor(s, 32);
        if (fq == 0 && !(DUPMASK && dry)) ssq[(size_t)row * 32 + pn * 4 + wc] = s;
    }
    __device__ __forceinline__ void operator()(const A4 (&acc)[2][2][4][2], const Unit& u, int wr, int wc, int fr, int fq) const {
        const int row0 = u.pm * 256 + wr * 64 + fr, col0 = u.pn * 256 + wc * 32 + 8 * fq;
        A4 xq[2][2][2]; float sq[2] = {0.f, 0.f};
        xload(xq[0], row0, col0); if (MODE == 1) sq[0] = s8[row0];
#pragma unroll
        for (int k = 0; k < 8; ++k) {
            const int ai = k >> 2, m = k & 3;
            if (k < 7) { const int rn = row0 + ((k + 1) >> 2) * 128 + ((k + 1) & 3) * 16; xload(xq[(k + 1) & 1], rn, col0); if (MODE == 1) sq[(k + 1) & 1] = s8[rn]; }
            const A4 a[2][2] = {{acc[ai][0][m][0], acc[ai][0][m][1]}, {acc[ai][1][m][0], acc[ai][1][m][1]}};
            group(a, xq[k & 1], row0 + ai * 128 + m * 16, col0, u.pn, wc, fq, sq[k & 1]);
            asm volatile("" ::: "memory");
        }
    }
    __device__ __forceinline__ void reduce(int ts, int grp, int tid) const {
        asm volatile("" : "+v"(tid));
        const int wid = tid >> 6, lane = tid & 63, wr = wid >> 2, wc = wid & 3, fr = lane & 15, fq = lane >> 4, ai = grp >> 2, m = grp & 3;
        A4 a[2][2];
#pragma unroll
        for (int bj = 0; bj < 2; ++bj) { const bf16* p = slab + (size_t)(ts * 8) * SLAB + (size_t)(grp * 2 + bj) * 4096 + (size_t)tid * 8; float t[8]; unpack8(*(const v4u*)p, t);
#pragma unroll
            for (int sl = 1; sl < 8; ++sl) { p += SLAB; LAUNDER_G(p, "+v"); float x[8]; unpack8(*(const v4u*)p, x);
#pragma unroll
                for (int j = 0; j < 8; ++j) t[j] += x[j]; }
            a[bj][0] = (A4){t[0], t[1], t[2], t[3]}; a[bj][1] = (A4){t[4], t[5], t[6], t[7]}; }
        { const int row = (MP / 256 + (ts >> 3)) * 256 + ai * 128 + wr * 64 + m * 16 + fr, col0 = (ts & 7) * 256 + wc * 32 + 8 * fq; A4 x[2][2]; xload(x, row, col0); group(a, x, row, col0, ts & 7, wc, fq, MODE == 1 ? s8[row] : 0.f); }
    }
};
__device__ __forceinline__ void rstd_rows(const float* ssq, float* rstd, int b, int tid) {
    asm volatile("" : "+v"(tid));
    const int row = b * 64 + (tid >> 3), part = tid & 7;
    if (row < MP) { const f32x4 x = *(const f32x4*)(ssq + (size_t)row * 32 + part * 4); float s = (x.x + x.y) + (x.z + x.w);
        s += __shfl_xor(s, 1); s += __shfl_xor(s, 2); s += __shfl_xor(s, 4);
        if (part == 0) rstd[row] = rsqrtf(s * (1.0f / DM) + EPS); }
}
struct EpiFFN1 {
    static constexpr bool PERM = true, AFTER_DRAIN = false, CHAIN = false;
    bf16* FH; const float* ssq; const float* rstd; float* s8;
    __device__ __forceinline__ void operator()(const A4 (&acc)[2][2][4][2], const Unit& u, int wr, int wc, int fr, int fq) const {
        const int row0 = u.pm * 256 + wr * 64 + fr, col0 = u.pn * 128 + wc * 32 + 8 * fq;
        float rs[2][4]; row_rstd(ssq, row0, fq, rs, u.pm < MP / 256 ? rstd : nullptr);
        if (u.pn == 0 && wc == 0 && fq == 0) {
#pragma unroll
            for (int ai = 0; ai < 2; ++ai)
#pragma unroll
                for (int m = 0; m < 4; ++m) s8[row0 + ai * 128 + m * 16] = X8_SCALE * rs[ai][m]; }
#pragma unroll
        for (int ai = 0; ai < 2; ++ai)
#pragma unroll
            for (int m = 0; m < 4; ++m) {
                const float r = rs[ai][m], c1 = r * -1.44269504f, ir2 = __builtin_amdgcn_rcpf(r * r); float f[8];
#pragma unroll
                for (int n = 0; n < 2; ++n)
#pragma unroll
                    for (int j = 0; j < 4; ++j) { const float g = acc[ai][0][m][n][j], uu = acc[ai][1][m][n][j]; f[4 * n + j] = (g * uu) * __builtin_amdgcn_rcpf(__builtin_fmaf(__builtin_amdgcn_exp2f(g * c1), ir2, ir2)); }
                *(v4u*)(FH + (size_t)(row0 + ai * 128 + m * 16) * DFF + col0) = pack8(f);
            }
    }
};

struct CvItem { const float* W; const float* gain; bf16* WT; unsigned char* WT8; int ldw, src_n0, k0, ldt, dst_n0, dst8_n0; };
__device__ __forceinline__ void cv_load(const CvItem& I, f32x4 (&v)[16], f32x4 (&g)[2], int lane) {
    const int kq = lane >> 4, n4 = (lane & 15) * 4, c = lane & 7;
#pragma unroll
    for (int i = 0; i < 16; ++i) v[i] = __builtin_nontemporal_load((const f32x4*)(I.W + (size_t)(I.k0 + 4 * i + kq) * I.ldw + I.src_n0 + n4));
    if (I.gain) { g[0] = *(const f32x4*)(I.gain + I.k0 + 8 * c); g[1] = *(const f32x4*)(I.gain + I.k0 + 8 * c + 4); }
    else { g[0] = (f32x4){1.f, 1.f, 1.f, 1.f}; g[1] = g[0]; }
}
__device__ __forceinline__ void cv_store(const CvItem& I, const f32x4 (&v)[16], const f32x4 (&g)[2], LAS float* scr, int lane) {
    const int kq = lane >> 4, n4 = (lane & 15) * 4, c = lane & 7;
#pragma unroll
    for (int i = 0; i < 16; ++i) { LAS float* p = scr + (4 * i + kq) * 65 + n4; p[0] = v[i].x; p[1] = v[i].y; p[2] = v[i].z; p[3] = v[i].w; }
    LDS_WAIT();
#pragma unroll
    for (int j = 0; j < 8; ++j) { const int n = (lane >> 3) + 8 * j; const LAS float* sp = scr + (8 * c) * 65 + n;
        const float f[8] = {sp[0 * 65] * g[0].x, sp[1 * 65] * g[0].y, sp[2 * 65] * g[0].z, sp[3 * 65] * g[0].w, sp[4 * 65] * g[1].x, sp[5 * 65] * g[1].y, sp[6 * 65] * g[1].z, sp[7 * 65] * g[1].w};
        if (I.WT8) { v2u o; o.x = pack4_i8(f[0], f[1], f[2], f[3], W8_SCALE); o.y = pack4_i8(f[4], f[5], f[6], f[7], W8_SCALE); *(v2u*)(I.WT8 + (size_t)(I.dst8_n0 + n) * I.ldt + I.k0 + 8 * c) = o; }
        if (I.WT) *(v4u*)(I.WT + (size_t)(I.dst_n0 + n) * I.ldt + I.k0 + 8 * c) = pack8(f); }
    LDS_WAIT();
}
constexpr int IT_IN = 32 * 96, IT_GATE = 32 * 96, IT_CO = 16 * 32, IT_GLU = 16 * 16, IT_SO = 16 * 32, IT_GO = 16 * 32, IT_O = 32 * 32, IT_F1 = 32 * 176, IT_F2 = 88 * 32;
constexpr int IT_LAYER = IT_IN + IT_GATE + IT_CO + IT_GLU + IT_SO + IT_GO + IT_O + IT_F1 + IT_F2;
constexpr int BG_A = 4096, BG_B = BG_A + 6656, BG_C = BG_B + 3072;
__device__ __forceinline__ void cv_decode(KArgs* kargs, unsigned char* wl, int l, int r, CvItem& I) {
    I.gain = nullptr; I.WT8 = nullptr; I.dst8_n0 = 0;
    if (r < IT_IN)   { const int kb = r / 96, nb = r % 96, nd = 64 * nb, wt = nb >> 2;
                       I.W = INP(I_WIN) + (size_t)l * DM * DIN; I.ldw = DIN; I.k0 = 64 * kb; I.WT = (bf16*)(wl + W_1); I.ldt = DM; I.dst_n0 = nd; I.gain = INP(I_NMIX) + l * DM;
                       if (wt < NB16) { int src = h_tile16(wt) * 256 + (nd & 255);
                           if (src >= OFF_CG && src < OFF_US) { const int q = src - OFF_CG; src = (((q >> 7) & 1) ? OFF_HC : OFF_CG) + 128 * (q >> 8) + (q & 127); }
                           I.src_n0 = src; }
                       else { I.src_n0 = h_tile8(wt - NB16) * 256 + (nd & 255); I.WT8 = wl + W_1G; I.dst8_n0 = nd - NB16 * 256; }
                       return; } r -= IT_IN;
    if (r < IT_GATE) { const int kb = r / 96, nb = r % 96; I.W = INP(I_WGATE) + (size_t)l * DM * DIN; I.ldw = DIN; I.src_n0 = 64 * nb; I.k0 = 64 * kb; I.WT = nullptr; I.ldt = DM; I.dst_n0 = 0; I.gain = INP(I_NMIX) + l * DM;
                       I.WT8 = wl + W_1G; I.dst8_n0 = NH8 * 256 + 64 * nb; return; } r -= IT_GATE;
    if (r < IT_CO)   { const int kb = r / 32, nb = r % 32; I.W = INP(I_WCO) + (size_t)l * WM * DM; I.ldw = DM; I.src_n0 = 64 * nb; I.k0 = 64 * kb; I.WT = (bf16*)(wl + W_M); I.ldt = Y3W; I.dst_n0 = 64 * nb; return; } r -= IT_CO;
    if (r < IT_GLU)  { const int kb = r / 16, nb = r % 16; I.W = INP(I_WGLU) + (size_t)l * WM * WM; I.ldw = WM; I.src_n0 = 64 * nb; I.k0 = 64 * kb; I.WT = (bf16*)(wl + W_GLU); I.ldt = WM; I.dst_n0 = 64 * nb; return; } r -= IT_GLU;
    if (r < IT_SO)   { const int kb = r / 32, nb = r % 32; I.W = INP(I_WSO) + (size_t)l * WM * DM; I.ldw = DM; I.src_n0 = 64 * nb; I.k0 = 64 * kb; I.WT = (bf16*)(wl + W_M) + WM; I.ldt = Y3W; I.dst_n0 = 64 * nb; return; } r -= IT_SO;
    if (r < IT_GO)   { const int kb = r / 32, nb = r % 32; I.W = INP(I_WGO) + (size_t)l * WM * DM; I.ldw = DM; I.src_n0 = 64 * nb; I.k0 = 64 * kb; I.WT = (bf16*)(wl + W_M) + 2 * WM; I.ldt = Y3W; I.dst_n0 = 64 * nb; return; } r -= IT_GO;
    if (r < IT_O)    { const int kb = r / 32, nb = r % 32; I.W = INP(I_WO) + (size_t)l * DM * DM; I.ldw = DM; I.src_n0 = 64 * nb; I.k0 = 64 * kb; I.WT = (bf16*)(wl + W_O); I.ldt = DM; I.dst_n0 = 64 * nb; return; } r -= IT_O;
    if (r < IT_F1)   { const int kb = r / 176, nb = r % 176; const int nd = 64 * nb;
                       I.W = INP(I_WF1) + (size_t)l * DM * 2 * DFF; I.ldw = 2 * DFF; I.src_n0 = ((nd >> 7) & 1) * DFF + 128 * (nd >> 8) + (nd & 127); I.k0 = 64 * kb; I.WT = (bf16*)(wl + W_F1); I.ldt = DM; I.dst_n0 = nd;
                       I.gain = INP(I_NFFN) + l * DM; return; } r -= IT_F1;
    { const int kb = r / 32, nb = r % 32; I.W = INP(I_WF2) + (size_t)l * DFF * DM; I.ldw = DM; I.src_n0 = 64 * nb; I.k0 = 64 * kb; I.WT = (bf16*)(wl + W_F2); I.ldt = DFF; I.dst_n0 = 64 * nb; }
}
__device__ __forceinline__ void convert_weights_layer(const Frame& F0, int l, int w0, int nw, int it_lo = 0, int it_hi = IT_LAYER) {
    SITE(F0);
    KARGS();
    LAS float* scr = (LAS float*)(F.lds + F.wave * 16640);
    unsigned char* wl = F.ws + WS_W + (size_t)l * W_LAYER;
    int it = it_lo + w0;
    if (it >= it_hi) return;
    CvItem A, B; f32x4 va[16], vb[16], ga[2], gb[2];
    cv_decode(kargs, wl, l, it, A); cv_load(A, va, ga, F.lane);
    for (;;) {
        it += nw; const bool hb = it < it_hi;
        if (hb) { cv_decode(kargs, wl, l, it, B); cv_load(B, vb, gb, F.lane); }
        cv_store(A, va, ga, scr, F.lane);
        if (!hb) break;
        it += nw; const bool ha = it < it_hi;
        if (ha) { cv_decode(kargs, wl, l, it, A); cv_load(A, va, ga, F.lane); }
        cv_store(B, vb, gb, scr, F.lane);
        if (!ha) break;
    }
}
__device__ __forceinline__ void prologue_x(const Frame& F0) {
    SITE(F0);
    KARGS();
    const int gw = F.vcu * NWAVES + F.wave, NGW = F.G * NWAVES;
    float* ssq = WSP(float, WS_SSQ); bf16* XB = WSP(bf16, WS_XB);
    for (int r = gw; r < M; r += NGW) {
        const float* src = r < MP ? INP(I_XP) + (size_t)r * DM : INP(I_XS) + (size_t)(r - MP) * DM;
        f32x4 v[8]; float s = 0.f;
#pragma unroll
        for (int j = 0; j < 8; ++j) { v[j] = ((const f32x4*)src)[F.lane + 64 * j]; s += (v[j].x * v[j].x + v[j].y * v[j].y) + (v[j].z * v[j].z + v[j].w * v[j].w); }
        s = wave_sum(s);
#pragma unroll
        for (int j = 0; j < 8; ++j) { v2u w; w.x = cvt_pk(v[j].x, v[j].y); w.y = cvt_pk(v[j].z, v[j].w); ((v2u*)(XB + (size_t)r * DM))[F.lane + 64 * j] = w; }
        const float rstd = rsqrtf(s * (1.0f / DM) + EPS), sc = X8_SCALE * rstd;
#pragma unroll
        for (int j = 0; j < 8; ++j) ((unsigned*)(F.ws + WS_XB8 + (size_t)r * DM))[F.lane + 64 * j] = pack4_i8(v[j].x, v[j].y, v[j].z, v[j].w, sc);
        if (F.lane < 32) ssq[(size_t)r * 32 + F.lane] = F.lane == 0 ? s : 0.f;
        if (F.lane == 0) { WSP(float, WS_RSTD)[r] = rstd; WSP(float, WS_S8)[r] = sc; }
    }
}
__device__ __forceinline__ void prologue_ssm(const Frame& F0) {
    SITE(F0);
    KARGS();
    for (int idx = (F.vcu * NWAVES + F.wave) * 64 + F.lane; idx < DEPTH * SG * SP; idx += F.G * NTHREADS) {
        const int l = idx / (SG * SP), gp = idx % (SG * SP), g = gp / SP, p = gp % SP;
        const double lre = INP(I_LRE)[idx], lim = INP(I_LIM)[idx], dt = exp((double)INP(I_LDT)[l * SG + g]);
        const double ar = lre * dt, ai = lim * dt, mag = exp(ar), lbr = mag * cos(ai), lbi = mag * sin(ai);
        ((f32x2*)(F.ws + WS_SSMC + (size_t)l * SSMC_LAYER + SSMC_LB))[gp] = (f32x2){(float)lbr, (float)lbi};
        unsigned char* tab = F.ws + WS_TAB + (size_t)l * TAB_LAYER;
        double pr = lbr, pi = lbi;
#pragma unroll
        for (int k = 0; k < 5; ++k) { const double t = pr * pr - pi * pi; pi = 2.0 * pr * pi; pr = t; }
        f32x2* pw = (f32x2*)(tab + T_LPOW) + (size_t)gp * 14;
        double qr = pr, qi = pi;
#pragma unroll
        for (int j = 0; j < 8; ++j) { pw[j] = (f32x2){(float)qr, (float)qi}; if (j < 7) { const double t = qr * pr - qi * pi; qi = qr * pi + qi * pr; qr = t; } }
#pragma unroll
        for (int k = 0; k < 6; ++k) { pw[8 + k] = (f32x2){(float)qr, (float)qi}; const double t = qr * qr - qi * qi; qi = 2.0 * qr * qi; qr = t; }
        const double nr = lbr - 1.0, ni = lbi, den = lre * lre + lim * lim, cr = (nr * lre + ni * lim) / den, ci = (ni * lre - nr * lim) / den;
        bf16* bbt = (bf16*)(tab + T_BBT) + (size_t)g * 4 * 32 * 16;
        bf16* cmt = (bf16*)(tab + T_CMT) + (size_t)g * 16 * 128;
#pragma unroll
        for (int i = 0; i < SI; ++i) {
            const double br = INP(I_BRE)[(size_t)idx * SI + i], bi = INP(I_BIM)[(size_t)idx * SI + i];
            const unsigned w = cvt_pk((float)(cr * br - ci * bi), (float)(cr * bi + ci * br));
            bbt[(((p >> 5)) * 32 + (p & 31)) * 16 + i] = (bf16)(w & 0xffffu);
            bbt[((2 + (p >> 5)) * 32 + (p & 31)) * 16 + i] = (bf16)(w >> 16);
            const size_t ci_ = (((size_t)l * SG + g) * SI + i) * SP + p;
            const unsigned wc = cvt_pk(INP(I_CRE)[ci_], -INP(I_CIM)[ci_]);
            cmt[i * 128 + p] = (bf16)(wc & 0xffffu); cmt[i * 128 + 64 + p] = (bf16)(wc >> 16);
        }
    }
}

__device__ __forceinline__ void phase_conv(const Frame& F0, int l) {
    SITE(F0);
    KARGS();
    const bf16* H = WSP(bf16, WS_H); bf16* ZA = WSP(bf16, WS_Y3);
    const float* cw = INP(I_CONVW) + (size_t)l * 3 * WM; const float* cache = INP(I_CACHE) + (size_t)l * NSB * 2 * WM;
    const size_t NT = (size_t)F.G * NTHREADS;
    for (size_t it = (size_t)F.vcu * NTHREADS + F.tid; it < (size_t)M * 128; it += NT) {
        const int r = (int)(it >> 7), c = (int)(it & 127) * 8;
        const bool samp = r >= MP; const int b = samp ? (r - MP) >> 5 : 0, t = samp ? (r - MP) & 31 : r;
        const bf16* hr = H + (size_t)r * DIN;
        float z0[8], z1[8], z2[8], bg[8];
        unpack8(*(const v4u*)(hr + OFF_CG + c), z0);
        if (t >= 1) unpack8(*(const v4u*)(hr - DIN + OFF_CG + c), z1);
        else {
#pragma unroll
            for (int j = 0; j < 8; ++j) z1[j] = samp ? cache[((size_t)b * 2 + 1) * WM + c + j] : 0.f; }
        if (t >= 2) unpack8(*(const v4u*)(hr - 2 * DIN + OFF_CG + c), z2);
        else {
#pragma unroll
            for (int j = 0; j < 8; ++j) z2[j] = samp ? cache[((size_t)b * 2 + t) * WM + c + j] : 0.f; }
        unpack8(*(const v4u*)(hr + OFF_BG + c), bg);
        float f[8];
#pragma unroll
        for (int j = 0; j < 8; ++j) f[j] = bg[j] * (cw[c + j] * z2[j] + cw[WM + c + j] * z1[j] + cw[2 * WM + c + j] * z0[j]);
        *(v4u*)(ZA + (size_t)r * Y3W + c) = pack8(f);
        const int tl = samp ? LSQ : MP;
        if (t >= tl - 2) {
            float* o = samp ? F.out + O_CONVS + (((size_t)l * NSB + b) * 2 + (t - (tl - 2))) * WM + c : F.out + O_CONVP + ((size_t)l * 2 + (t - (tl - 2))) * WM + c;
            *(f32x4*)o = (f32x4){z0[0], z0[1], z0[2], z0[3]}; *(f32x4*)(o + 4) = (f32x4){z0[4], z0[5], z0[6], z0[7]};
        }
    }
}
__device__ __forceinline__ void phase_ln(const Frame& F0, int l) {
    SITE(F0);
    KARGS();
    const bf16* H = WSP(bf16, WS_H); bf16* VN = WSP(bf16, WS_VN); const float* lg = INP(I_LNV) + (size_t)l * WM;
    const int gw = F.vcu * NWAVES + F.wave, NGW = F.G * NWAVES;
    for (int r = gw; r < M; r += NGW) {
        float v[16];
#pragma unroll
        for (int h = 0; h < 2; ++h) { float t[8]; unpack8(*(const v4u*)(H + (size_t)r * DIN + OFF_VG + 8 * F.lane + 512 * h), t);
#pragma unroll
            for (int j = 0; j < 8; ++j) v[8 * h + j] = gelu_t(t[j]); }
        float s = 0.f;
#pragma unroll
        for (int j = 0; j < 16; ++j) s += v[j];
        const float mean = wave_sum(s) * (1.0f / WM); float q = 0.f;
#pragma unroll
        for (int j = 0; j < 16; ++j) { v[j] -= mean; q += v[j] * v[j]; }
        const float rstd = rsqrtf(wave_sum(q) * (1.0f / WM) + EPS);
#pragma unroll
        for (int h = 0; h < 2; ++h) { const int c = 8 * F.lane + 512 * h; float f[8];
            const f32x4 g0 = *(const f32x4*)(lg + c), g1 = *(const f32x4*)(lg + c + 4);
#pragma unroll
            for (int j = 0; j < 4; ++j) { f[j] = v[8 * h + j] * rstd * g0[j]; f[4 + j] = v[8 * h + 4 + j] * rstd * g1[j]; }
            *(v4u*)(VN + (size_t)r * WM + c) = pack8(f);
            if (r >= MP) { float* o = F.out + O_VS + ((size_t)l * NSB * LSQ + (r - MP)) * WM + c; *(f32x4*)o = (f32x4){f[0], f[1], f[2], f[3]}; *(f32x4*)(o + 4) = (f32x4){f[4], f[5], f[6], f[7]}; }
        }
    }
}
__device__ __forceinline__ void prologue_wsb(const Frame& F0) {
    SITE(F0);
    KARGS();
    for (int idx = (F.vcu * NWAVES + F.wave) * 64 + F.lane; idx < DEPTH * 8 * 128 * 128; idx += F.G * NTHREADS) {
        const int l = idx >> 17, rem = idx & 131071, t = (rem >> 7) & 127, s = rem & 127;
        const float v = s <= t ? INP(I_WS)[idx] : 0.f;
        ((bf16*)(F.ws + WS_TAB + (size_t)l * TAB_LAYER + T_WSB))[rem] = (bf16)(cvt_pk(v, 0.f) & 0xffffu);
    }
}
__device__ __forceinline__ void phase_sgu_m(const Frame& F0, int l) {
    SITE(F0);
    KARGS();
    const bf16* H = WSP(bf16, WS_H); const bf16* VN = WSP(bf16, WS_VN); bf16* YC = WSP(bf16, WS_Y3) + 2 * WM;
    const bf16* WSb = (const bf16*)(F.ws + WS_TAB + (size_t)l * TAB_LAYER + T_WSB);
    const float* bs = INP(I_BS) + (size_t)l * 8 * 128;
    LAS bf16* vt = (LAS bf16*)F.lds;
    const int r = F.lane & 31, hh = F.lane >> 5, w = F.wave;
    const int rp = 16 * ((r >> 2) & 1) + 4 * (r >> 3) + (r & 3);
    for (int bu = F.vcu; bu < 1024 + 64; bu += F.G) {
        if (bu < 1024) {
            const int c = bu >> 3, h = bu & 7, r0 = c * 128;
            v4u vv[4];
#pragma unroll
            for (int k = 0; k < 4; ++k) { const int q = F.tid + NTHREADS * k, s = q >> 4, dg = q & 15; vv[k] = *(const v4u*)(VN + (size_t)(r0 + s) * WM + h * 128 + 8 * dg); }
            const int tb = w & 3, db0 = (w >> 2) * 2;
            const bf16* wrow = WSb + ((size_t)h * 128 + 32 * tb + r) * 128 + 8 * hh;
            bf16x8 bfrs[8];
#pragma unroll
            for (int ks = 0; ks < 8; ++ks) bfrs[ks] = *(const bf16x8*)(wrow + 16 * ks);
            const int t = 32 * tb + r; const float bias = bs[h * 128 + t]; const size_t row = (size_t)(r0 + t);
            v4u ugw[2][2];
#pragma unroll
            for (int e = 0; e < 2; ++e)
#pragma unroll
                for (int hq = 0; hq < 2; ++hq) ugw[e][hq] = *(const v4u*)(H + row * DIN + OFF_UG + h * 128 + 32 * (db0 + e) + 16 * hh + 8 * hq);
            __syncthreads();
#pragma unroll
            for (int k = 0; k < 4; ++k) {
                const int q = F.tid + NTHREADS * k, s = q >> 4, dg = q & 15;
                const v4u v = vv[k];
                const int col = (((s >> 3) ^ dg) << 3) + (s & 7);
                LAS bf16* p = vt + (8 * dg) * 136 + col;
                p[0 * 136] = (bf16)(v.x & 0xffffu); p[1 * 136] = (bf16)(v.x >> 16); p[2 * 136] = (bf16)(v.y & 0xffffu); p[3 * 136] = (bf16)(v.y >> 16);
                p[4 * 136] = (bf16)(v.z & 0xffffu); p[5 * 136] = (bf16)(v.z >> 16); p[6 * 136] = (bf16)(v.w & 0xffffu); p[7 * 136] = (bf16)(v.w >> 16);
            }
            LDS_WAIT();
            __syncthreads();
            f32x16 acc[2];
#pragma unroll
            for (int e = 0; e < 2; ++e)
#pragma unroll
                for (int i = 0; i < 16; ++i) acc[e][i] = 0.f;
#pragma unroll
            for (int ks = 0; ks < 8; ++ks) if (ks < 2 * tb + 2) {
                const bf16x8 bfr = bfrs[ks];
#pragma unroll
                for (int e = 0; e < 2; ++e) { const int d = 32 * (db0 + e) + rp, m = (2 * ks + hh) ^ ((d >> 3) & 15);
                    const bf16x8 afr = *(const LAS bf16x8*)(vt + d * 136 + m * 8);
                    acc[e] = MFMA32(afr, bfr, acc[e]); }
            }
#pragma unroll
            for (int e = 0; e < 2; ++e)
#pragma unroll
                for (int hq = 0; hq < 2; ++hq) {
                    const int ch = h * 128 + 32 * (db0 + e) + 16 * hh + 8 * hq;
                    float ug[8], f[8]; unpack8(ugw[e][hq], ug);
#pragma unroll
                    for (int j = 0; j < 8; ++j) f[j] = gelu_t(ug[j]) * (acc[e][8 * hq + j] + bias);
                    *(v4u*)(YC + row * Y3W + ch) = pack8(f);
                }
        } else {
            const int su = bu - 1024, h = su & 7, bq = su >> 3;
            v4u vv[4];
#pragma unroll
            for (int k = 0; k < 4; ++k) { const int q = F.tid, s = q >> 4, dg = q & 15; vv[k] = *(const v4u*)(VN + (size_t)(MP + (4 * bq + k) * 32 + s) * WM + h * 128 + 8 * dg); }
            const int bb = w >> 1, db0 = (w & 1) * 2;
            const bf16* wrow = WSb + ((size_t)h * 128 + r) * 128 + 8 * hh;
            bf16x8 bfrs[2];
#pragma unroll
            for (int ks = 0; ks < 2; ++ks) bfrs[ks] = *(const bf16x8*)(wrow + 16 * ks);
            const int t = r; const float bias = bs[h * 128 + t]; const size_t row = (size_t)(MP + (4 * bq + bb) * 32 + t);
            v4u ugw[2][2];
#pragma unroll
            for (int e = 0; e < 2; ++e)
#pragma unroll
                for (int hq = 0; hq < 2; ++hq) ugw[e][hq] = *(const v4u*)(H + row * DIN + OFF_UG + h * 128 + 32 * (db0 + e) + 16 * hh + 8 * hq);
            __syncthreads();
#pragma unroll
            for (int k = 0; k < 4; ++k) {
                const int q = F.tid, s = q >> 4, dg = q & 15;
                const v4u v = vv[k];
                const int col = (((s >> 3) ^ (dg & 3)) << 3) + (s & 7);
                LAS bf16* p = vt + k * (128 * 40) + (8 * dg) * 40 + col;
                p[0 * 40] = (bf16)(v.x & 0xffffu); p[1 * 40] = (bf16)(v.x >> 16); p[2 * 40] = (bf16)(v.y & 0xffffu); p[3 * 40] = (bf16)(v.y >> 16);
                p[4 * 40] = (bf16)(v.z & 0xffffu); p[5 * 40] = (bf16)(v.z >> 16); p[6 * 40] = (bf16)(v.w & 0xffffu); p[7 * 40] = (bf16)(v.w >> 16);
            }
            LDS_WAIT();
            __syncthreads();
            f32x16 acc[2];
#pragma unroll
            for (int e = 0; e < 2; ++e)
#pragma unroll
                for (int i = 0; i < 16; ++i) acc[e][i] = 0.f;
#pragma unroll
            for (int ks = 0; ks < 2; ++ks) {
                const bf16x8 bfr = bfrs[ks];
#pragma unroll
                for (int e = 0; e < 2; ++e) { const int d = 32 * (db0 + e) + rp, m = (2 * ks + hh) ^ ((d >> 3) & 3);
                    const bf16x8 afr = *(const LAS bf16x8*)(vt + bb * (128 * 40) + d * 40 + m * 8);
                    acc[e] = MFMA32(afr, bfr, acc[e]); }
            }
#pragma unroll
            for (int e = 0; e < 2; ++e)
#pragma unroll
                for (int hq = 0; hq < 2; ++hq) {
                    const int ch = h * 128 + 32 * (db0 + e) + 16 * hh + 8 * hq;
                    float ug[8], f[8]; unpack8(ugw[e][hq], ug);
#pragma unroll
                    for (int j = 0; j < 8; ++j) f[j] = gelu_t(ug[j]) * (acc[e][8 * hq + j] + bias);
                    *(v4u*)(YC + row * Y3W + ch) = pack8(f);
                }
        }
    }
}
#define S5_ROTATE(S, lam0, lam1) do { _Pragma("unroll") for (int i_ = 0; i_ < 16; ++i_) { \
        const float re0 = S[0][i_], im0 = S[2][i_], re1 = S[1][i_], im1 = S[3][i_]; \
        S[0][i_] = lam0.x * re0 - lam0.y * im0; S[2][i_] = lam0.x * im0 + lam0.y * re0; \
        S[1][i_] = lam1.x * re1 - lam1.y * im1; S[3][i_] = lam1.x * im1 + lam1.y * re1; } } while (0)
__device__ __forceinline__ void phase_s1m(const Frame& F0, int l) {
    SITE(F0);
    const bf16* H = WSP(bf16, WS_H); float* E2 = WSP(float, WS_E2);
    const unsigned char* tab = F.ws + WS_TAB + (size_t)l * TAB_LAYER;
    const f32x2* LB = (const f32x2*)(F.ws + WS_SSMC + (size_t)l * SSMC_LAYER + SSMC_LB);
    const int gw = F.vcu * NWAVES + F.wave, NGW = F.G * NWAVES, r = F.lane & 31, hh = F.lane >> 5;
    for (int task = F.wave * F.G + F.vcu; task < 1024; task += NGW) {
        const int g = task & 63, cb = task >> 6;
        bf16x8 bfr[4];
#pragma unroll
        for (int b = 0; b < 4; ++b) bfr[b] = *(const bf16x8*)((const bf16*)(tab + T_BBT) + (((size_t)g * 4 + b) * 32 + r) * 16 + 8 * hh);
        const f32x2 lam0 = LB[g * SP + r], lam1 = LB[g * SP + 32 + r];
        const bf16* up = H + (size_t)((cb * 32 + r) * CH) * DIN + OFF_US + g * SI + 8 * hh;
        f32x16 S[4];
#pragma unroll
        for (int b = 0; b < 4; ++b)
#pragma unroll
            for (int i = 0; i < 16; ++i) S[b][i] = 0.f;
        bf16x8 ub[4];
#pragma unroll
        for (int k = 0; k < 4; ++k) ub[k] = *(const bf16x8*)(up + (size_t)k * DIN);
        const bf16* pf = up + (size_t)4 * DIN;
#pragma unroll 1
        for (int t0 = 0; t0 < CH; t0 += 4) {
#pragma unroll
            for (int k = 0; k < 4; ++k) {
                const bf16x8 a = ub[k];
                if (t0 + 4 < CH) ub[k] = *(const bf16x8*)pf;
                pf += DIN; LAUNDER_G(pf, "+v");
                S5_ROTATE(S, lam0, lam1);
#pragma unroll
                for (int b = 0; b < 4; ++b) S[b] = MFMA32(a, bfr[b], S[b]);
            }
        }
#pragma unroll
        for (int b = 0; b < 4; ++b) {
            float* ep = E2 + ((((size_t)g * 2 + (b >> 1)) * SP + 32 * (b & 1) + r) * NCH) + cb * 32 + 4 * hh;
#pragma unroll
            for (int rq = 0; rq < 4; ++rq) *(f32x4*)(ep + 8 * rq) = (f32x4){S[b][4 * rq], S[b][4 * rq + 1], S[b][4 * rq + 2], S[b][4 * rq + 3]};
        }
    }
}
__device__ __forceinline__ void phase_s2m(const Frame& F0, int l) {
    SITE(F0);
    float* E2 = WSP(float, WS_E2);
    const int gw = F.vcu * NWAVES + F.wave, NGW = F.G * NWAVES;
    for (int task = gw; task < SG * SP; task += NGW) {
        const int g = task >> 6, p = task & 63;
        float* er = E2 + (((size_t)g * 2 + 0) * SP + p) * NCH + 8 * F.lane; float* ei = er + (size_t)SP * NCH;
        const f32x2* pw = (const f32x2*)(F.ws + WS_TAB + (size_t)l * TAB_LAYER + T_LPOW) + (size_t)task * 14;
        float ar[8], ai[8];
        { const f32x4 x0 = *(const f32x4*)er, x1 = *(const f32x4*)(er + 4), y0 = *(const f32x4*)ei, y1 = *(const f32x4*)(ei + 4);
          ar[0] = x0.x; ar[1] = x0.y; ar[2] = x0.z; ar[3] = x0.w; ar[4] = x1.x; ar[5] = x1.y; ar[6] = x1.z; ar[7] = x1.w;
          ai[0] = y0.x; ai[1] = y0.y; ai[2] = y0.z; ai[3] = y0.w; ai[4] = y1.x; ai[5] = y1.y; ai[6] = y1.z; ai[7] = y1.w; }
        const f32x2 q1 = pw[0];
#pragma unroll
        for (int j = 1; j < 8; ++j) { const float nr = q1.x * ar[j - 1] - q1.y * ai[j - 1] + ar[j], ni = q1.x * ai[j - 1] + q1.y * ar[j - 1] + ai[j]; ar[j] = nr; ai[j] = ni; }
        float xr = ar[7], xi = ai[7];
#pragma unroll
        for (int k = 0; k < 6; ++k) { const f32x2 rk = pw[8 + k]; const float yr = __shfl_up(xr, 1 << k), yi = __shfl_up(xi, 1 << k);
            if (F.lane >= (1 << k)) { xr += rk.x * yr - rk.y * yi; xi += rk.x * yi + rk.y * yr; } }
        float cr = __shfl_up(xr, 1), ci = __shfl_up(xi, 1);
        if (F.lane == 0) { cr = 0.f; ci = 0.f; }
        if (F.lane == 63) { F.out[O_SREP + ((size_t)l * SG + g) * SP + p] = xr; F.out[O_SIMP + ((size_t)l * SG + g) * SP + p] = xi; }
        float sr[8], si[8]; sr[0] = cr; si[0] = ci;
#pragma unroll
        for (int j = 1; j < 8; ++j) { const f32x2 qj = pw[j - 1]; sr[j] = ar[j - 1] + qj.x * cr - qj.y * ci; si[j] = ai[j - 1] + qj.x * ci + qj.y * cr; }
        *(f32x4*)er = (f32x4){sr[0], sr[1], sr[2], sr[3]}; *(f32x4*)(er + 4) = (f32x4){sr[4], sr[5], sr[6], sr[7]};
        *(f32x4*)ei = (f32x4){si[0], si[1], si[2], si[3]}; *(f32x4*)(ei + 4) = (f32x4){si[4], si[5], si[6], si[7]};
    }
}
__device__ __forceinline__ void phase_s3m(const Frame& F0, int l) {
    SITE(F0);
    KARGS();
    const bf16* H = WSP(bf16, WS_H); const float* E2 = WSP(float, WS_E2); bf16* YS = WSP(bf16, WS_YS);
    const unsigned char* tab = F.ws + WS_TAB + (size_t)l * TAB_LAYER;
    const f32x2* LB = (const f32x2*)(F.ws + WS_SSMC + (size_t)l * SSMC_LAYER + SSMC_LB);
    constexpr int SLP = 168;
    LAS bf16* sl = (LAS bf16*)(F.lds + F.wave * 16128);
    LAS bf16* cml = sl + 32 * SLP;
    { unsigned z = 0u; asm volatile("" : "+v"(z)); const v4u zz = {z, z, z, z};
      if (F.lane < 32) *(LAS v4u*)(sl + F.lane * SLP + 144) = zz, *(LAS v4u*)(sl + F.lane * SLP + 152) = zz; }
    const int gw = F.vcu * NWAVES + F.wave, NGW = F.G * NWAVES, r = F.lane & 31, hh = F.lane >> 5, c16 = F.lane & 15, q4 = F.lane >> 4;
    for (int task = F.wave * F.G + F.vcu; task < 1024 + 64; task += NGW) {
        const bool samp = task >= 1024; const int q = samp ? task - 1024 : task, g = q & 63, cb = q >> 6;
        bf16x8 bfr[4];
#pragma unroll
        for (int b = 0; b < 4; ++b) bfr[b] = *(const bf16x8*)((const bf16*)(tab + T_BBT) + (((size_t)g * 4 + b) * 32 + r) * 16 + 8 * hh);
#pragma unroll
        for (int k = 0; k < 4; ++k) { const int pc = F.lane + 64 * k, ii = pc >> 4, cc = (pc & 15) * 8;
            *(LAS bf16x8*)(cml + ii * SLP + cc) = *(const bf16x8*)((const bf16*)(tab + T_CMT) + ((size_t)g * 16 + ii) * 128 + cc); }
        { const int ii = F.lane >> 2, part = F.lane & 3; const unsigned dv = cvt_pk(INP(I_SD)[(size_t)l * WM + g * SI + ii], 0.f) & 0xffffu;
          v4u w = (v4u){0u, 0u, 0u, 0u}; const int e = ii - 8 * part;
          if (e >= 0 && e < 8) { const unsigned x = dv << (16 * (e & 1)); if ((e >> 1) == 0) w.x = x; else if ((e >> 1) == 1) w.y = x; else if ((e >> 1) == 2) w.z = x; else w.w = x; }
          *(LAS v4u*)(cml + ii * SLP + 128 + 8 * part) = w; }
        const f32x2 lam0 = LB[g * SP + r], lam1 = LB[g * SP + 32 + r];
        const size_t rowA = samp ? (size_t)(MP + r * LSQ) : (size_t)((cb * 32 + r) * CH);
        const bf16* up = H + rowA * DIN + OFF_US + g * SI + 8 * hh;
        f32x16 S[4];
        if (samp) {
            int hh1 = hh; asm volatile("" : "+v"(hh1));
#pragma unroll
            for (int b = 0; b < 4; ++b) { const float* st = (b < 2 ? INP(I_STRE) : INP(I_STIM)) + (size_t)l * NSB * SG * SP + (size_t)g * SP + 32 * (b & 1) + r + (size_t)(4 * hh1) * SG * SP;
#pragma unroll
                for (int i = 0; i < 16; ++i) S[b][i] = st[(size_t)((i & 3) + 8 * (i >> 2)) * SG * SP]; }
        } else {
#pragma unroll
            for (int b = 0; b < 4; ++b) { const float* ep = E2 + ((((size_t)g * 2 + (b >> 1)) * SP + 32 * (b & 1) + r) * NCH) + cb * 32 + 4 * hh;
#pragma unroll
                for (int rq = 0; rq < 4; ++rq) { const f32x4 x = *(const f32x4*)(ep + 8 * rq); S[b][4 * rq] = x.x; S[b][4 * rq + 1] = x.y; S[b][4 * rq + 2] = x.z; S[b][4 * rq + 3] = x.w; } }
        }
        const int ch = g * SI + 4 * q4;
        bf16* yo[2];
#pragma unroll
        for (int cblk = 0; cblk < 2; ++cblk) { const size_t row = samp ? (size_t)(MP + (16 * cblk + c16) * LSQ) : (size_t)((cb * 32 + 16 * cblk + c16) * CH);
            yo[cblk] = YS + row * WM + ch; }
        bf16x8 ub[4];
#pragma unroll
        for (int k = 0; k < 4; ++k) ub[k] = *(const bf16x8*)(up + (size_t)k * DIN);
        const bf16* pf = up + (size_t)4 * DIN;
#pragma unroll 1
        for (int t0 = 0; t0 < CH; t0 += 4) {
#pragma unroll
            for (int k = 0; k < 4; ++k) {
                const bf16x8 a = ub[k];
                if (t0 + 4 < CH) ub[k] = *(const bf16x8*)pf;
                pf += DIN; LAUNDER_G(pf, "+v");
                S5_ROTATE(S, lam0, lam1);
#pragma unroll
                for (int b = 0; b < 4; ++b) S[b] = MFMA32(a, bfr[b], S[b]);
#pragma unroll
                for (int b = 0; b < 4; ++b)
#pragma unroll
                    for (int i = 0; i < 16; i += 2) { const unsigned w = cvt_pk(S[b][i], S[b][i + 1]); LAS bf16* p = sl + ((i & 3) + 8 * (i >> 2) + 4 * hh) * SLP + 32 * b + r;
                        p[0] = (bf16)(w & 0xffffu); p[SLP] = (bf16)(w >> 16); }
                *(LAS bf16x8*)(sl + r * SLP + 128 + 8 * hh) = a;
                LDS_WAIT();
#pragma unroll
                for (int cblk = 0; cblk < 2; ++cblk) {
                    f32x4 y = (f32x4){0.f, 0.f, 0.f, 0.f};
#pragma unroll
                    for (int ks = 0; ks < 5; ++ks) { const bf16x8 sb = *(const LAS bf16x8*)(sl + (16 * cblk + c16) * SLP + 32 * ks + 8 * q4); const bf16x8 ca = *(const LAS bf16x8*)(cml + c16 * SLP + 32 * ks + 8 * q4); y = MFMA16(ca, sb, y); }
                    v2u o; o.x = cvt_pk(gelu_t(y[0]), gelu_t(y[1])); o.y = cvt_pk(gelu_t(y[2]), gelu_t(y[3]));
                    *(v2u*)yo[cblk] = o;
                    yo[cblk] += WM; LAUNDER_G(yo[cblk], "+v");
                }
                LDS_WAIT();
                __builtin_amdgcn_sched_barrier(0);
            }
        }
        if (samp) {
            int hh2 = hh; asm volatile("" : "+v"(hh2));
#pragma unroll
            for (int b = 0; b < 4; ++b) { float* so = F.out + (b < 2 ? O_SRES : O_SIMS) + (size_t)l * NSB * SG * SP + (size_t)g * SP + 32 * (b & 1) + r + (size_t)(4 * hh2) * SG * SP;
#pragma unroll
                for (int i = 0; i < 16; ++i) so[(size_t)((i & 3) + 8 * (i >> 2)) * SG * SP] = S[b][i]; }
        }
    }
}
__device__ __forceinline__ void phase_final(const Frame& F0) {
    SITE(F0);
    KARGS();
    const int gw = F.vcu * NWAVES + F.wave, NGW = F.G * NWAVES; const float* gn = INP(I_NFIN); const bf16* XB = WSP(bf16, WS_XB);
    for (int r = gw; r < M; r += NGW) {
        float* yr = F.out + O_Y + (size_t)r * DM; float v[4][8]; float s = 0.f;
#pragma unroll
        for (int j = 0; j < 4; ++j) { unpack8(*(const v4u*)(XB + (size_t)r * DM + 8 * F.lane + 512 * j), v[j]);
#pragma unroll
            for (int e = 0; e < 8; ++e) s += v[j][e] * v[j][e]; }
        const float rstd = rsqrtf(wave_sum(s) * (1.0f / DM) + EPS);
#pragma unroll
        for (int j = 0; j < 4; ++j) { const int c = 8 * F.lane + 512 * j; const f32x4 g0 = *(const f32x4*)(gn + c), g1 = *(const f32x4*)(gn + c + 4);
            *(f32x4*)(yr + c) = (f32x4){v[j][0] * rstd * g0.x, v[j][1] * rstd * g0.y, v[j][2] * rstd * g0.z, v[j][3] * rstd * g0.w};
            *(f32x4*)(yr + c + 4) = (f32x4){v[j][4] * rstd * g1.x, v[j][5] * rstd * g1.y, v[j][6] * rstd * g1.z, v[j][7] * rstd * g1.w}; }
    }
}

constexpr int PH_PER_LAYER = 9, N_PHASES = 2 + DEPTH * PH_PER_LAYER;

__global__ void __launch_bounds__(NTHREADS, 2) fwd(Args args) {
    extern __shared__ __attribute__((aligned(16))) unsigned char lds_raw[];
    Frame F;
    F.lds = (LAS unsigned char*)lds_raw;
    F.tid = threadIdx.x; F.lane = F.tid & 63; F.wave = __builtin_amdgcn_readfirstlane(F.tid >> 6);
    F.G = gridDim.x; { const int bx = blockIdx.x; F.vcu = (F.G % 8 == 0) ? (bx % 8) * (F.G / 8) + bx / 8 : bx; }
    F.out = args.out; F.ws = args.ws;
    volatile LAS unsigned* misc = (volatile LAS unsigned*)(F.lds + MISC_OFF);
    if (F.tid < 16) misc[F.tid] = 0u;
    __syncthreads();
    const int lo = args.ph_lo, hi = args.ph_hi;
    unsigned* barw = (unsigned*)(F.ws + WS_CTL) + 4096;
    XcdBarrier bar; bar.bar = barw; bar.x = 0; bar.st = misc; bar.wave = (unsigned)F.wave;
    if (hi - lo > 1) bar = xcd_barrier_post(barw, misc, (unsigned)F.wave);
#define IN(k) (lo <= (k) && (k) < hi)
#define SEAM(k) do { if (IN(k) && IN((k) + 1)) { xcd_barrier(bar); if (DUPMASK & 2048) xcd_barrier(bar); } } while (0)
    const int blk = (int)blockIdx.x;
    const bool bgconv = (F.G == 256) && (hi - lo > 1);
    const bool split = (F.G == 256) && (hi - lo > 1);

    if ((PHMASK & 1) && IN(0)) DUP(1) {
        if (rep_) xcd_barrier(bar);
        const int gw = F.vcu * NWAVES + F.wave, NGW = F.G * NWAVES;
        for (int l = 0; l < DEPTH; ++l) if (l == 0 || !bgconv) convert_weights_layer(F, l, gw, NGW, 0, IT_LAYER);
        prologue_x(F); prologue_ssm(F); prologue_wsb(F);
    }
    SEAM(0);
    for (int l = 0; l < DEPTH; ++l) {
        const int pb = 1 + l * PH_PER_LAYER;
        const Frame& FK = F;
        if ((PHMASK & 2) && IN(pb + 0)) DUP(2) {
            SITE(FK); unsigned char* wl = F.ws + WS_W + (size_t)l * W_LAYER;
            if (rep_) xcd_barrier(bar);
            KARGS();
            pg8::Gemm g{WSP(bf16, WS_XB), (const bf16*)(wl + W_1), M, NB16 * 256, DM, DM, DM, F.ws}; pg8::StaticOrder S; S.init(MP, NB16 * 256, F.G, blk, DM, M - MP, 0, 24, 0);
            EpiH E{WSP(bf16, WS_H), WSP(float, WS_SSQ), split ? WSP(float, WS_RSTD) : nullptr};
            pg8::gemm_phase<EpiH, pg8::StaticOrder, true, true>(F.lds, g, S, E, F.tid);
            pg8::Gemm g8{WSP(bf16, WS_XB8), (const bf16*)(wl + W_1G), M, (48 - NB16) * 256, DM / 2, DM / 2, DM / 2, F.ws}; pg8::StaticOrder S8o; S8o.init(MP, (48 - NB16) * 256, F.G, F.G == 256 ? (blk + 160) & 255 : blk, DM / 2, M - MP, 0, 24, NH8);
            EpiG8 E8{WSP(bf16, WS_H), WSP(bf16, WS_G), WSP(float, WS_SSQ), INP(I_BGATE) + (size_t)l * DIN, split ? WSP(float, WS_RSTD) : nullptr, WSP(float, WS_S8)};
            pg8::gemm_phase<EpiG8, pg8::StaticOrder, true, true, true>(F.lds, g8, S8o, E8, F.tid);
            if (l + 1 < DEPTH && bgconv && blk >= 192) convert_weights_layer(F, l + 1, (blk - 192) * NWAVES + F.wave, 64 * NWAVES, BG_B, BG_C);
        }
        SEAM(pb + 0);
        if ((PHMASK & 4) && IN(pb + 1)) DUP(4) { if (rep_) xcd_barrier(bar); DUP(4096) phase_conv(F, l); DUP(8192) phase_ln(F, l); DUP(16384) phase_s1m(F, l);
            if (l + 1 < DEPTH && bgconv && F.wave >= 4) convert_weights_layer(F, l + 1, F.vcu * 4 + (F.wave - 4), F.G * 4, 0, BG_A); }
        SEAM(pb + 1);
        if ((PHMASK & 8) && IN(pb + 2)) { DUP(32768) phase_s2m(F, l); DUP(8) { if (rep_) xcd_barrier(bar); phase_sgu_m(F, l); } }
        SEAM(pb + 2);
        if ((PHMASK & 16) && IN(pb + 3)) DUP(16) { if (rep_) xcd_barrier(bar); phase_s3m(F, l);
            if (l + 1 < DEPTH && bgconv && F.wave >= 5) convert_weights_layer(F, l + 1, F.vcu * 3 + (F.wave - 5), F.G * 3, BG_A, BG_B); }
        SEAM(pb + 3);
        if ((PHMASK & 32) && IN(pb + 4)) DUP(32) {
            SITE(FK); unsigned char* wl = F.ws + WS_W + (size_t)l * W_LAYER;
            if (rep_) xcd_barrier(bar);
            KARGS();
            pg8::Gemm g{WSP(bf16, WS_YS), (const bf16*)(wl + W_GLU), M, WM, WM, WM, WM, F.ws}; pg8::StaticOrder S; S.init(MP, WM, F.G, blk, WM, split ? 0 : M - MP);
            EpiGLU E{WSP(bf16, WS_YS), WSP(bf16, WS_Y3) + WM, INP(I_BGLU) + (size_t)l * WM, WSP(bf16, WS_H)};
            pg8::gemm_phase<EpiGLU, pg8::StaticOrder, true, true>(F.lds, g, S, E, F.tid);
            if (split) {
                pg8::SliceOrder S2; S2.init(blk, MP / 256, WM, 4, 1, 4); EpiSlab E2{WSP(bf16, WS_H), 4, 4};
                pg8::gemm_phase<EpiSlab, pg8::SliceOrder, true, true>(F.lds, g, S2, E2, F.tid);
                xcd_barrier(bar); if (blk < 128) E.reduce(blk >> 3, blk & 7, F.tid);
            }
        }
        SEAM(pb + 4);
        if ((PHMASK & 64) && IN(pb + 5)) DUP(64) {
            SITE(FK); unsigned char* wl = F.ws + WS_W + (size_t)l * W_LAYER;
            if (rep_) xcd_barrier(bar);
            pg8::Gemm g{WSP(bf16, WS_Y3), (const bf16*)(wl + W_M), M, DM, WM, Y3W, Y3W, F.ws}; pg8::ChainOrder S; S.init(MP, DM, F.G, blk, WM, split ? 0 : M - MP);
            EpiMrgC E{WSP(bf16, WS_G), WSP(bf16, WS_MG), WSP(bf16, WS_H)};
            pg8::gemm_phase<EpiMrgC, pg8::ChainOrder, true, true>(F.lds, g, S, E, F.tid);
            if (split) {
                pg8::SliceOrder S2; S2.init(blk, MP / 256, WM, 2, 3); EpiSlab E2{WSP(bf16, WS_H), 6, 8};
                pg8::gemm_phase<EpiSlab, pg8::SliceOrder, true, true>(F.lds, g, S2, E2, F.tid);
                xcd_barrier(bar); E.reduce(blk >> 3, blk & 7, F.tid);
            }
        }
        SEAM(pb + 5);
        if ((PHMASK & 128) && IN(pb + 6)) {
            SITE(FK); unsigned char* wl = F.ws + WS_W + (size_t)l * W_LAYER;
            pg8::Gemm g{WSP(bf16, WS_MG), (const bf16*)(wl + W_O), M, DM, DM, DM, DM, F.ws}; pg8::StaticOrder S; S.init(MP, DM, F.G, blk, DM, split ? 0 : M - MP);
            KARGS();
            EpiRes<0> E{F.out + O_Y, WSP(bf16, WS_XB), WSP(float, WS_SSQ), WSP(bf16, WS_H), 0, INP(I_XP), INP(I_XS) - (size_t)MP * DM, l == 0, nullptr, nullptr};
            DUP(128) {
            E.dry = (DUPMASK & 128) && rep_ == 0; if (rep_) xcd_barrier(bar);
            pg8::gemm_phase<EpiRes<0>, pg8::StaticOrder, true, true>(F.lds, g, S, E, F.tid);
            if (split) {
                pg8::SliceOrder S2; S2.init(blk, MP / 256, DM, 8, 1); EpiSlab E2{WSP(bf16, WS_H), 8, 8};
                pg8::gemm_phase<EpiSlab, pg8::SliceOrder, true, true>(F.lds, g, S2, E2, F.tid);
                xcd_barrier(bar); E.reduce(blk >> 3, blk & 7, F.tid); rstd_rows(WSP(float, WS_SSQ), WSP(float, WS_RSTD), blk, F.tid);
            }
            }
        }
        SEAM(pb + 6);
        if ((PHMASK & 256) && IN(pb + 7)) DUP(256) {
            SITE(FK); unsigned char* wl = F.ws + WS_W + (size_t)l * W_LAYER;
            if (rep_) xcd_barrier(bar);
            pg8::Gemm g{WSP(bf16, WS_XB), (const bf16*)(wl + W_F1), M, 2 * DFF, DM, DM, DM, F.ws}; pg8::StaticOrder S; S.init(MP, 2 * DFF, F.G, blk, DM, M - MP);
            EpiFFN1 E{WSP(bf16, WS_G), WSP(float, WS_SSQ), split ? WSP(float, WS_RSTD) : nullptr, WSP(float, WS_S8)};
            pg8::gemm_phase<EpiFFN1, pg8::StaticOrder, true, true>(F.lds, g, S, E, F.tid);
            if (l + 1 < DEPTH && bgconv && blk >= 176) convert_weights_layer(F, l + 1, (blk - 176) * NWAVES + F.wave, 80 * NWAVES, BG_C, IT_LAYER);
        }
        SEAM(pb + 7);
        if ((PHMASK & 512) && IN(pb + 8)) {
            SITE(FK); unsigned char* wl = F.ws + WS_W + (size_t)l * W_LAYER;
            pg8::Gemm g{WSP(bf16, WS_G), (const bf16*)(wl + W_F2), M, DM, DFF, DFF, DFF, F.ws}; pg8::StaticOrder S; S.init(MP, DM, F.G, blk, DFF, split ? 0 : M - MP);
            EpiRes<1> E{F.out + O_Y, WSP(bf16, WS_XB), WSP(float, WS_SSQ), WSP(bf16, WS_H), 0, nullptr, nullptr, 0, F.ws + WS_XB8, WSP(float, WS_S8)};
            DUP(512) {
            E.dry = (DUPMASK & 512) && rep_ == 0; if (rep_) xcd_barrier(bar);
            pg8::gemm_phase<EpiRes<1>, pg8::StaticOrder, true, true>(F.lds, g, S, E, F.tid);
            if (split) {
                pg8::SliceOrder S2; S2.init(blk, MP / 256, DFF, 8, 1); EpiSlab E2{WSP(bf16, WS_H), 8, 8};
                pg8::gemm_phase<EpiSlab, pg8::SliceOrder, true, true>(F.lds, g, S2, E2, F.tid);
                xcd_barrier(bar); E.reduce(blk >> 3, blk & 7, F.tid); rstd_rows(WSP(float, WS_SSQ), WSP(float, WS_RSTD), blk, F.tid);
            }
            }
        }
        SEAM(pb + 8);
    }
    if ((PHMASK & 1024) && IN(N_PHASES - 1)) phase_final(F);
#undef IN
#undef SEAM
}

#ifndef PHMASK
#define PHMASK 2047
#endif
#ifndef MK_N_LAUNCHES
#define MK_N_LAUNCHES 1
#endif
extern "C" void kernel_launch(void* const* d_in, const int* in_sizes, int n_in, void* d_out, int out_size, void* d_ws, size_t ws_size, hipStream_t stream) {
    static int grid = 0;
    if (grid == 0) {
        if (n_in != N_IN || (size_t)out_size != O_END || ws_size < WS_END) { fprintf(stderr, "kernel_launch: unexpected shapes: n_in %d out %d ws %zu (need %zu)\n", n_in, out_size, ws_size, (size_t)WS_END); grid = -1; return; }
        int dev = 0, cus = 0, per_cu = 0;
        if (hipGetDevice(&dev) != hipSuccess || hipDeviceGetAttribute(&cus, hipDeviceAttributeMultiprocessorCount, dev) != hipSuccess) { grid = -1; return; }
        if (hipFuncSetAttribute((const void*)fwd, hipFuncAttributeMaxDynamicSharedMemorySize, LDS_BYTES) != hipSuccess) { fprintf(stderr, "kernel_launch: hipFuncSetAttribute failed\n"); grid = -1; return; }
        if (hipOccupancyMaxActiveBlocksPerMultiprocessor(&per_cu, (const void*)fwd, NTHREADS, LDS_BYTES) != hipSuccess || per_cu < 1) fprintf(stderr, "kernel_launch: occupancy query says %d\n", per_cu);
        (void)hipGetLastError();
        grid = cus;
    }
    if (grid < 0) return;
    (void)hipMemsetAsync((char*)d_ws + WS_CTL, 0, CTL_ZERO_BYTES, stream);
    Args a{};
    for (int i = 0; i < N_IN; ++i) a.in[i] = (const float*)d_in[i];
    a.out = (float*)d_out; a.ws = (unsigned char*)d_ws;
    if (MK_N_LAUNCHES == 1) { a.ph_lo = 0; a.ph_hi = N_PHASES; hipLaunchKernelGGL(fwd, dim3(grid), dim3(NTHREADS), LDS_BYTES, stream, a); }
    else for (int p = 0; p < N_PHASES; ++p) { a.ph_lo = p; a.ph_hi = p + 1; hipLaunchKernelGGL(fwd, dim3(grid), dim3(NTHREADS), LDS_BYTES, stream, a); }
}
```
